# Optimizing an MI355X kernel written in HIP

```python
import math
import jax, jax.numpy as jnp
from jax import lax
import numpy as np

D_MODEL = 1024
BATCH = 32
SEQ = 256
DEPTH = 1
DEC_BATCH = 4
DEC_SEQ = 4096
PAST_LEN = 512

GRID_W = 64
H_DIFF = 4
DH_DIFF = 64
H_GQA = 8
H_KV = 2
DH_GQA = 64
G_GQA = H_GQA // H_KV
D_FF = 2816
QBLK = 128
ROPE_THETA = 10000.0
EPS = 1e-6
N_MOD = 9

DQ_DIFF = H_DIFF * 2 * DH_DIFF
DQ_GQA = H_GQA * DH_GQA
DKV_GQA = H_KV * DH_GQA
D_IN = 3 * DQ_DIFF + DQ_GQA + 2 * DKV_GQA
D_MIX = DQ_DIFF + DQ_GQA
SPLITS = (DQ_DIFF, 2 * DQ_DIFF, 3 * DQ_DIFF, 3 * DQ_DIFF + DQ_GQA, 3 * DQ_DIFF + DQ_GQA + DKV_GQA)

kernel_name = "hybrid_diffattn_gqa_prefix_dit_step"


def lambda_init(layer_idx):
    return 0.8 - 0.6 * math.exp(-0.3 * layer_idx)


def rmsnorm(x, g):
    xf = x.astype(jnp.float32)
    y = xf * lax.rsqrt(jnp.mean(xf * xf, axis=-1, keepdims=True) + EPS)
    return (y * g.astype(jnp.float32)).astype(x.dtype)


def ada_mod(cvec, w, b):
    m = jax.nn.silu(cvec) @ w + b
    return m.reshape(*cvec.shape[:-1], N_MOD, D_MODEL)


def modulate(x, g, shift, scale):
    return rmsnorm(x, g) * (1 + scale[..., None, :]) + shift[..., None, :]


def swiglu(h, w_gu, w_down):
    g, u = jnp.split(h @ w_gu, 2, axis=-1)
    return (jax.nn.silu(g) * u) @ w_down


def ffn_sublayer(x, mod, i, g, w_gu, w_down):
    shift, scale, gate = mod[..., 3 * i, :], mod[..., 3 * i + 1, :], mod[..., 3 * i + 2, :]
    return x + 0.5 * gate[..., None, :] * swiglu(modulate(x, g, shift, scale), w_gu, w_down)


def axial_rope(n_tokens, head_dim):
    rows = n_tokens // GRID_W
    row = jnp.repeat(jnp.arange(rows), GRID_W)
    col = jnp.tile(jnp.arange(GRID_W), rows)
    half = head_dim // 2
    inv = ROPE_THETA ** (-jnp.arange(0, half, 2, dtype=jnp.float32) / half)
    ang = jnp.stack([row[:, None] * inv, col[:, None] * inv], axis=1)
    return jnp.cos(ang), jnp.sin(ang)


def apply_rope(x, cos, sin):
    B, T, H, d = x.shape
    xs = x.astype(jnp.float32).reshape(B, T, H, 2, 2, d // 4)
    x1, x2 = xs[..., 0, :], xs[..., 1, :]
    c = cos[None, :, None]
    s = sin[None, :, None]
    out = jnp.stack([x1 * c - x2 * s, x1 * s + x2 * c], axis=-2)
    return out.reshape(B, T, H, d).astype(x.dtype)


def sweep_query_blocks(fn, qs):
    T = qs[0].shape[1]
    nb = T // QBLK
    blocks = tuple(jnp.moveaxis(q.reshape(q.shape[0], nb, QBLK, *q.shape[2:]), 1, 0) for q in qs)
    out = lax.map(lambda qb: fn(*qb), blocks)
    return jnp.moveaxis(out, 0, 1).reshape(out.shape[1], T, *out.shape[3:])


def diff_attn_block(q, k, v, lam):
    s = jnp.einsum('bqhmd,bkhmd->bhmqk', q, k).astype(jnp.float32) * (DH_DIFF ** -0.5)
    p = jax.nn.softmax(s, axis=-1)
    a = p[:, :, 0] - lam * p[:, :, 1]
    return jnp.einsum('bhqk,bkhe->bqhe', a.astype(v.dtype), v)


def gqa_block(q, k, v):
    s = jnp.einsum('bqngd,bknd->bngqk', q, k).astype(jnp.float32) * (DH_GQA ** -0.5)
    p = jax.nn.softmax(s, axis=-1)
    return jnp.einsum('bngqk,bknd->bqngd', p.astype(v.dtype), v)


def mixer_projections(h, w_in, q_norm, k_norm):
    B, T, _ = h.shape
    dq, dk, dv, gq, gk, gv = jnp.split(h @ w_in, list(SPLITS), axis=-1)
    dq = dq.reshape(B, T, H_DIFF, 2, DH_DIFF)
    dk = dk.reshape(B, T, H_DIFF, 2, DH_DIFF)
    dv = dv.reshape(B, T, H_DIFF, 2 * DH_DIFF)
    gq = rmsnorm(gq.reshape(B, T, H_GQA, DH_GQA), q_norm)
    gk = rmsnorm(gk.reshape(B, T, H_KV, DH_GQA), k_norm)
    gv = gv.reshape(B, T, H_KV, DH_GQA)
    return dq, dk, dv, gq, gk, gv


def rope_pairs(x, cos, sin):
    B, T, H, M, d = x.shape
    return apply_rope(x.reshape(B, T, H * M, d), cos, sin).reshape(B, T, H, M, d)


def diff_lambda(lq1, lk1, lq2, lk2, lam_init):
    f = jnp.float32
    return (jnp.exp(jnp.sum(lq1.astype(f) * lk1.astype(f)))
            - jnp.exp(jnp.sum(lq2.astype(f) * lk2.astype(f))) + lam_init)


def mixer_output(o_diff, o_gqa, subln_g, lam_init, w_out):
    B, T = o_diff.shape[:2]
    o_diff = rmsnorm(o_diff, subln_g) * (1.0 - lam_init)
    o = jnp.concatenate([o_diff.reshape(B, T, DQ_DIFF), o_gqa.reshape(B, T, DQ_GQA)], axis=-1)
    return o @ w_out


def setup_inputs(seed: int = 0) -> dict:
    key = jax.random.key(seed)
    ks = jax.random.split(key, 32)
    f = jnp.float32

    def nrm(k, shape, scale=1.0):
        return jax.random.normal(k, shape, f) * scale

    def gain(k, shape):
        return 1.0 + 0.05 * jax.random.normal(k, shape, f)

    return {
        "x_prompt": nrm(ks[0], (BATCH, SEQ, D_MODEL)),
        "x_sample": nrm(ks[1], (DEC_BATCH, DEC_SEQ, D_MODEL)),
        "c": nrm(ks[2], (DEC_BATCH, D_MODEL)),
        "cache_diff_k": nrm(ks[3], (DEC_BATCH, DEPTH, PAST_LEN, H_DIFF, 2, DH_DIFF)),
        "cache_diff_v": nrm(ks[4], (DEC_BATCH, DEPTH, PAST_LEN, H_DIFF, 2 * DH_DIFF)),
        "cache_gqa_k": nrm(ks[5], (DEC_BATCH, DEPTH, PAST_LEN, H_KV, DH_GQA)),
        "cache_gqa_v": nrm(ks[6], (DEC_BATCH, DEPTH, PAST_LEN, H_KV, DH_GQA)),
        "c_ctx": nrm(ks[7], (D_MODEL,)),
        "w_ada": nrm(ks[8], (DEPTH, D_MODEL, N_MOD * D_MODEL), 0.5 * D_MODEL ** -0.5),
        "b_ada": nrm(ks[9], (DEPTH, N_MOD * D_MODEL), 0.02),
        "norm_ff1": gain(ks[10], (DEPTH, D_MODEL)),
        "w_ff1_gu": nrm(ks[11], (DEPTH, D_MODEL, 2 * D_FF), D_MODEL ** -0.5),
        "w_ff1_down": nrm(ks[12], (DEPTH, D_FF, D_MODEL), D_FF ** -0.5),
        "norm_mix": gain(ks[13], (DEPTH, D_MODEL)),
        "w_in": nrm(ks[14], (DEPTH, D_MODEL, D_IN), D_MODEL ** -0.5),
        "q_norm": gain(ks[15], (DEPTH, DH_GQA)),
        "k_norm": gain(ks[16], (DEPTH, DH_GQA)),
        "lambda_q1": nrm(ks[17], (DEPTH, DH_DIFF), 0.1),
        "lambda_k1": nrm(ks[18], (DEPTH, DH_DIFF), 0.1),
        "lambda_q2": nrm(ks[19], (DEPTH, DH_DIFF), 0.1),
        "lambda_k2": nrm(ks[20], (DEPTH, DH_DIFF), 0.1),
        "subln": gain(ks[21], (DEPTH, 2 * DH_DIFF)),
        "w_out": nrm(ks[22], (DEPTH, D_MIX, D_MODEL), D_MIX ** -0.5),
        "norm_ff2": gain(ks[23], (DEPTH, D_MODEL)),
        "w_ff2_gu": nrm(ks[24], (DEPTH, D_MODEL, 2 * D_FF), D_MODEL ** -0.5),
        "w_ff2_down": nrm(ks[25], (DEPTH, D_FF, D_MODEL), D_FF ** -0.5),
        "final_norm": gain(ks[26], (D_MODEL,)),
    }


def reference(x_prompt, x_sample, c, cache_diff_k, cache_diff_v, cache_gqa_k, cache_gqa_v,
              c_ctx, w_ada, b_ada, norm_ff1, w_ff1_gu, w_ff1_down, norm_mix, w_in,
              q_norm, k_norm, lambda_q1, lambda_k1, lambda_q2, lambda_k2, subln, w_out,
              norm_ff2, w_ff2_gu, w_ff2_down, final_norm):
    xc = x_prompt
    Bc, Tc = xc.shape[:2]
    new_dk, new_dv, new_gk, new_gv = [], [], [], []
    for l in range(DEPTH):
        lam_init = lambda_init(l)
        lam = diff_lambda(lambda_q1[l], lambda_k1[l], lambda_q2[l], lambda_k2[l], lam_init)
        mod = ada_mod(c_ctx, w_ada[l], b_ada[l])
        xc = ffn_sublayer(xc, mod, 0, norm_ff1[l], w_ff1_gu[l], w_ff1_down[l])
        h = modulate(xc, norm_mix[l], mod[..., 3, :], mod[..., 4, :])
        dq, dk, dv, gq, gk, gv = mixer_projections(h, w_in[l], q_norm[l], k_norm[l])
        o_diff = sweep_query_blocks(lambda q, dk=dk, dv=dv: diff_attn_block(q, dk, dv, lam), (dq,))
        o_gqa = sweep_query_blocks(lambda q, gk=gk, gv=gv: gqa_block(q, gk, gv),
                                   (gq.reshape(Bc, Tc, H_KV, G_GQA, DH_GQA),))
        xc = xc + mod[..., 5, :][..., None, :] * mixer_output(o_diff, o_gqa, subln[l], lam_init, w_out[l])
        xc = ffn_sublayer(xc, mod, 2, norm_ff2[l], w_ff2_gu[l], w_ff2_down[l])
        new_dk.append(dk)
        new_dv.append(dv)
        new_gk.append(gk)
        new_gv.append(gv)
    y_prompt = rmsnorm(xc, final_norm)
    new_diff_k = jnp.stack(new_dk, axis=1)
    new_diff_v = jnp.stack(new_dv, axis=1)
    new_gqa_k = jnp.stack(new_gk, axis=1)
    new_gqa_v = jnp.stack(new_gv, axis=1)

    xs = x_sample
    Bs, Ts = xs.shape[:2]
    cos_d, sin_d = axial_rope(Ts, DH_DIFF)
    cos_g, sin_g = axial_rope(Ts, DH_GQA)
    for l in range(DEPTH):
        lam_init = lambda_init(l)
        lam = diff_lambda(lambda_q1[l], lambda_k1[l], lambda_q2[l], lambda_k2[l], lam_init)
        mod = ada_mod(c, w_ada[l], b_ada[l])
        xs = ffn_sublayer(xs, mod, 0, norm_ff1[l], w_ff1_gu[l], w_ff1_down[l])
        h = modulate(xs, norm_mix[l], mod[..., 3, :], mod[..., 4, :])
        dq, dk, dv, gq, gk, gv = mixer_projections(h, w_in[l], q_norm[l], k_norm[l])
        dq = rope_pairs(dq, cos_d, sin_d)
        dk = rope_pairs(dk, cos_d, sin_d)
        gq = apply_rope(gq, cos_g, sin_g)
        gk = apply_rope(gk, cos_g, sin_g)
        dk_all = jnp.concatenate([cache_diff_k[:, l], dk], axis=1)
        dv_all = jnp.concatenate([cache_diff_v[:, l], dv], axis=1)
        gk_all = jnp.concatenate([cache_gqa_k[:, l], gk], axis=1)
        gv_all = jnp.concatenate([cache_gqa_v[:, l], gv], axis=1)
        o_diff = sweep_query_blocks(lambda q, k=dk_all, v=dv_all: diff_attn_block(q, k, v, lam), (dq,))
        o_gqa = sweep_query_blocks(lambda q, k=gk_all, v=gv_all: gqa_block(q, k, v),
                                   (gq.reshape(Bs, Ts, H_KV, G_GQA, DH_GQA),))
        xs = xs + mod[..., 5, :][..., None, :] * mixer_output(o_diff, o_gqa, subln[l], lam_init, w_out[l])
        xs = ffn_sublayer(xs, mod, 2, norm_ff2[l], w_ff2_gu[l], w_ff2_down[l])
    y_sample = rmsnorm(xs, final_norm)

    return (y_prompt, y_sample, new_diff_k, new_diff_v, new_gqa_k, new_gqa_v)
```

```cpp
#include <hip/hip_runtime.h>
#include <hip/hip_cooperative_groups.h>
#include <hip/hip_bf16.h>
#include <cstdio>
#include <cstdint>
#include <cmath>
namespace cg = cooperative_groups;
namespace pg8 {
#define PG8_LAS __attribute__((address_space(3)))
typedef unsigned short bf16_t;
typedef short bf16x8 __attribute__((ext_vector_type(8)));
typedef float f32x4 __attribute__((ext_vector_type(4)));
typedef unsigned u32x4 __attribute__((ext_vector_type(4)));
constexpr int BM = 256, BK = 64, HALF = 128, HTB = HALF * BK * 2  , STAGE_BYTES = 8 * HTB, NXCD = 8, WGM = 8;

__host__ __device__ __forceinline__ int lds_byte(int r, int c) { const int st = (r >> 4) * 2 + (c >> 5), rr = r & 15, cc = c & 31, ob = rr * 64 + cc * 2; return st * 1024 + (ob ^ (((ob >> 9) & 1) << 5)); }
__host__ __device__ __forceinline__ void stage_rc(int b, int& R, int& C) { const int st = b / 1024, sb = b % 1024, swz = sb ^ (((sb >> 9) & 1) << 5); R = (st >> 1) * 16 + swz / 64; C = (st & 1) * 32 + (swz % 64) / 2; }
__host__ __device__ __forceinline__ int perm32(int rho) { const int n = rho >> 4, i = rho & 15; return 8 * (i >> 2) + 4 * n + (i & 3); }

struct Unit { int pm, pn; };
struct Gemm { const bf16_t* A; const bf16_t* Bt; int M, N, K; };

struct StaticOrder {
    int nM, nN, nwg, G, c;
    __host__ __device__ void init(int M, int N, int G_, int c_) { nM = M / BM; nN = N / BM; nwg = nM * nN; G = G_; c = c_; }
    __host__ __device__ bool next(int i, Unit& u) const {
        const long L = (long)i * G + c; if (L >= nwg) return false;
        int wgid = (int)L; { const int q = nwg / NXCD, r = nwg % NXCD, xcd = wgid % NXCD, off = wgid / NXCD; wgid = (xcd < r ? xcd * (q + 1) : r * (q + 1) + (xcd - r) * q) + off; }
        const int nig = WGM * nN, gid = wgid / nig, fm = gid * WGM, gsz = (nM - fm) < WGM ? (nM - fm) : WGM;
        u.pm = fm + ((wgid % nig) % gsz); u.pn = (wgid % nig) / gsz; return true;
    }
    __device__ __forceinline__ void a_ready(const Unit&) const {}
    __device__ __forceinline__ void done(const Unit&) const {}
};

__device__ __forceinline__ unsigned cvt_pk_bf16(float lo, float hi) { unsigned r; asm volatile("v_cvt_pk_bf16_f32 %0, %1, %2" : "=v"(r) : "v"(lo), "v"(hi)); return r; }
typedef float f32x2 __attribute__((ext_vector_type(2)));
typedef unsigned u32x2 __attribute__((ext_vector_type(2)));
constexpr float ATT_C2 = 0.125f * 1.4426950408889634f;
constexpr int NTOK = 24576, NCTX = 8192, DMODEL = 1024, DFF = 2816, NMODV = 9216;
constexpr int OFF_DK = 25165824, OFF_DV = 29360128, OFF_GK = 33554432, OFF_GV = 34603008;
__device__ __forceinline__ float silu_f(float g) { return g * __builtin_amdgcn_rcpf(1.0f + __builtin_amdgcn_exp2f(-1.4426950408889634f * g)); }
struct EpiSwiglu {
    static constexpr bool PERM = true, AFTER_DRAIN = false;
    bf16_t* O;
    __device__ __forceinline__ void operator()(const f32x4 (&acc)[2][2][4][2], const Unit& u, int wr, int wc, int fr_, int fq_) const {
        int fr = fr_, fq = fq_; asm volatile("" : "+v"(fr), "+v"(fq));
        const int row0 = u.pm * BM + wr * 64 + fr, col0 = u.pn * 128 + wc * 32 + 8 * fq;
#pragma unroll
        for (int ai = 0; ai < 2; ++ai)
#pragma unroll
            for (int m = 0; m < 4; ++m) {
                bf16_t* rowp = O + (size_t)(row0 + ai * HALF + m * 16) * DFF + col0;
                const f32x4 g0 = acc[ai][0][m][0], g1 = acc[ai][0][m][1], u0 = acc[ai][1][m][0], u1 = acc[ai][1][m][1];
                u32x4 w;
                w.x = cvt_pk_bf16(silu_f(g0[0]) * u0[0], silu_f(g0[1]) * u0[1]); w.y = cvt_pk_bf16(silu_f(g0[2]) * u0[2], silu_f(g0[3]) * u0[3]);
                w.z = cvt_pk_bf16(silu_f(g1[0]) * u1[0], silu_f(g1[1]) * u1[1]); w.w = cvt_pk_bf16(silu_f(g1[2]) * u1[2], silu_f(g1[3]) * u1[3]);
                *(u32x4*)rowp = w;
            }
    }
};
struct EpiResid {
    static constexpr bool PERM = false, AFTER_DRAIN = false;
    const float* base; const float* base2; float* out; const float* mod; int gate_idx; float coef;
    __device__ __forceinline__ void operator()(const f32x4 (&acc)[2][2][4][2], const Unit& u, int wr, int wc, int fr_, int fq_) const {
        int fr = fr_, fq = fq_; asm volatile("" : "+v"(fr), "+v"(fq));
        const int mv = (u.pm < 32) ? 4 : ((u.pm - 32) >> 4);
        const float* gate = mod + mv * NMODV + gate_idx * DMODEL; const float* bs = (u.pm < 32) ? base : base2;
        const int row0 = u.pm * BM + wr * 64 + fr, col0 = u.pn * BM + wc * 32 + 4 * fq;
        f32x4 gv[2][2];
#pragma unroll
        for (int bj = 0; bj < 2; ++bj)
#pragma unroll
            for (int n = 0; n < 2; ++n) gv[bj][n] = *(const f32x4*)(gate + col0 + bj * HALF + n * 16) * coef;
#pragma unroll
        for (int ai = 0; ai < 2; ++ai)
#pragma unroll
            for (int m = 0; m < 4; ++m) {
                const size_t off = (size_t)(row0 + ai * HALF + m * 16) * DMODEL + col0;
#pragma unroll
                for (int bj = 0; bj < 2; ++bj)
#pragma unroll
                    for (int n = 0; n < 2; ++n) { const f32x4 b = *(const f32x4*)(bs + off + bj * HALF + n * 16); *(f32x4*)(out + off + bj * HALF + n * 16) = b + gv[bj][n] * acc[ai][bj][m][n]; }
                asm volatile("" ::: "memory");
            }
    }
};
struct EpiQKV {
    static constexpr bool PERM = false, AFTER_DRAIN = false;
    bf16_t *QB, *KB, *VB; float* out; const float* qn; const float* kn; const float* rope;
    __device__ __forceinline__ void operator()(const f32x4 (&acc)[2][2][4][2], const Unit& u, int wr, int wc, int fr_, int fq_) const {
        int fr = fr_, fq = fq_; asm volatile("" : "+v"(fr), "+v"(fq));
        const int ch = u.pn * 4 + wc; const bool ctx = u.pm < 32;
        int kind, cc;
        if (ch < 8) { kind = 0; cc = ch; } else if (ch < 16) { kind = 1; cc = ch - 8; } else if (ch < 24) { kind = 2; cc = ch - 16; } else if (ch < 32) { kind = 3; cc = ch - 24; } else if (ch < 34) { kind = 4; cc = ch - 32; } else { kind = 5; cc = ch - 34; }
        const bool do_norm = (kind == 3 || kind == 4), do_rope = !ctx && (kind == 0 || kind == 1 || kind == 3 || kind == 4);
        const float qscale = (kind == 0 || kind == 3) ? ATT_C2 : 1.0f;
        bf16_t* dst; int dpitch, dcol; float* fo = nullptr; int fpitch = 0, fcol = 0;
        if (kind == 0) { dst = QB; dpitch = 1024; dcol = 64 * cc; }
        else if (kind == 3) { dst = QB; dpitch = 1024; dcol = 512 + 64 * cc; }
        else if (kind == 1) { dst = KB; dpitch = 640; dcol = 64 * cc; fo = out + OFF_DK; fpitch = 512; fcol = 64 * cc; }
        else if (kind == 4) { dst = KB; dpitch = 640; dcol = 512 + 64 * cc; fo = out + OFF_GK; fpitch = 128; fcol = 64 * cc; }
        else if (kind == 2) { dst = VB; dpitch = 640; dcol = 64 * cc; fo = out + OFF_DV; fpitch = 512; fcol = 64 * cc; }
        else { dst = VB; dpitch = 640; dcol = 512 + 64 * cc; fo = out + OFF_GV; fpitch = 128; fcol = 64 * cc; }
        const bool isq = (kind == 0 || kind == 3);
        const float* gnorm = (kind == 3 ? qn : kn) + 4 * fq;
#pragma unroll
        for (int ai = 0; ai < 2; ++ai)
#pragma unroll
            for (int m = 0; m < 4; ++m) {
                const int row = u.pm * BM + ai * HALF + wr * 64 + m * 16 + fr;
                f32x4 v[2][2];
#pragma unroll
                for (int bj = 0; bj < 2; ++bj)
#pragma unroll
                    for (int n = 0; n < 2; ++n) v[bj][n] = acc[ai][bj][m][n];
                if (do_norm) {
                    float ss = 0.f;
#pragma unroll
                    for (int bj = 0; bj < 2; ++bj)
#pragma unroll
                        for (int n = 0; n < 2; ++n) { const f32x4 x = v[bj][n]; ss += (x[0] * x[0] + x[1] * x[1]) + (x[2] * x[2] + x[3] * x[3]); }
                    ss += __shfl_xor(ss, 16); ss += __shfl_xor(ss, 32);
                    const float r = 1.0f / sqrtf(ss * (1.0f / 64.0f) + 1e-6f);
#pragma unroll
                    for (int bj = 0; bj < 2; ++bj)
#pragma unroll
                        for (int n = 0; n < 2; ++n) v[bj][n] = v[bj][n] * r * *(const f32x4*)(gnorm + 32 * bj + 16 * n);
                }
                int drow = row;
                if (ctx) {
                    if (fo) {
#pragma unroll
                        for (int bj = 0; bj < 2; ++bj)
#pragma unroll
                            for (int n = 0; n < 2; ++n) *(f32x4*)(fo + (size_t)row * fpitch + fcol + 32 * bj + 16 * n + 4 * fq) = v[bj][n];
                    }
                } else {
                    const int tl = (row - NCTX) & 4095, lb = (row - NCTX) >> 12;
                    if (!isq) drow = NCTX + lb * 4608 + 512 + tl;
                    if (do_rope) {
#pragma unroll
                        for (int bj = 0; bj < 2; ++bj) {
                            const int pos = bj == 0 ? (tl >> 6) : (tl & 63);
                            const f32x4 c4 = *(const f32x4*)(rope + pos * 16 + 4 * fq), s4 = *(const f32x4*)(rope + 1024 + pos * 16 + 4 * fq);
                            const f32x4 x1 = v[bj][0], x2 = v[bj][1];
                            v[bj][0] = x1 * c4 - x2 * s4; v[bj][1] = x1 * s4 + x2 * c4;
                        }
                    }
                }
                bf16_t* dp = dst + (size_t)drow * dpitch + dcol + 4 * fq;
#pragma unroll
                for (int bj = 0; bj < 2; ++bj)
#pragma unroll
                    for (int n = 0; n < 2; ++n) { const f32x4 x = v[bj][n] * qscale; u32x2 w; w.x = cvt_pk_bf16(x[0], x[1]); w.y = cvt_pk_bf16(x[2], x[3]); *(u32x2*)(dp + 32 * bj + 16 * n) = w; }
                asm volatile("" ::: "memory"); __builtin_amdgcn_sched_barrier(0);
            }
    }
};
template <class Epi, class Sched, bool ALIGN_EPI = false, bool SP2 = false>
__device__ __forceinline__ void gemm_phase(PG8_LAS unsigned char* lds, const Gemm g, const Sched& S, const Epi& E) {
    const int tid = threadIdx.x, wid = __builtin_amdgcn_readfirstlane(tid >> 6), lane = tid & 63, wr = wid >> 2, wc = wid & 3, fr = lane & 15, fq = lane >> 4;
    const int K = g.K, nt = K / BK;
    unsigned voffA[2], voffB[2];
#pragma unroll
    for (int i = 0; i < 2; ++i) { int R, C; stage_rc(tid * 16 + i * 8192, R, C); const int Rb = Epi::PERM ? ((R & ~31) + perm32(R & 31)) : R;
        voffA[i] = (unsigned)(R * K + C) * 2u; voffB[i] = (unsigned)(Rb * K + C) * 2u; }
    const size_t kstep = (size_t)(BK * 2);
    const size_t hstep = (size_t)HALF * K * 2;
    const size_t tstep = 2 * hstep;
    const unsigned ldsw = (unsigned)wid * 1024u;
    const int aoff = lds_byte(wr * 64 + fr, fq * 8), boff = lds_byte(wc * 32 + fr, fq * 8);
#define PG8_SA(b, h) (((b) * 2 + (h)) * HTB)
#define PG8_SB(b, h) ((4 + (b) * 2 + (h)) * HTB)
#define PG8_STAGE(bufoff, gbase, voff) do { _Pragma("unroll") for (int _i = 0; _i < 2; ++_i) \
        __builtin_amdgcn_global_load_lds((const unsigned*)((const char*)(gbase) + (voff)[_i]), (PG8_LAS unsigned*)(lds + (bufoff) + ldsw + _i * 8192), 16, 0, 0); } while (0)
#define PG8_LDA(dst, b, h) do { _Pragma("unroll") for (int m = 0; m < 4; ++m) _Pragma("unroll") for (int k = 0; k < 2; ++k) dst[m][k] = *(const PG8_LAS bf16x8*)(lds + PG8_SA(b, h) + aoff + m * 2048 + k * 1024); } while (0)
#define PG8_LDB(dst, b, h) do { _Pragma("unroll") for (int n = 0; n < 2; ++n) _Pragma("unroll") for (int k = 0; k < 2; ++k) dst[n][k] = *(const PG8_LAS bf16x8*)(lds + PG8_SB(b, h) + boff + n * 2048 + k * 1024); } while (0)
#define PG8_MMA(ai, bj, At, Bt) do { __builtin_amdgcn_s_setprio(1); _Pragma("unroll") for (int m = 0; m < 4; ++m) _Pragma("unroll") for (int n = 0; n < 2; ++n) _Pragma("unroll") for (int k = 0; k < 2; ++k) \
        acc[ai][bj][m][n] = __builtin_amdgcn_mfma_f32_16x16x32_bf16(Bt[n][k], At[m][k], acc[ai][bj][m][n], 0, 0, 0); __builtin_amdgcn_s_setprio(0); } while (0)
#define PG8_WAIT_V(n) asm volatile("s_waitcnt vmcnt(" #n ")" ::: "memory")
#define PG8_WAIT_L(n) asm volatile("s_waitcnt lgkmcnt(" #n ")" ::: "memory")
#define PG8_BAR __builtin_amdgcn_s_barrier()
#define PG8_SCHED __builtin_amdgcn_sched_barrier(0)
    Unit cur, nxt; int ui = 0;
    if (!S.next(0, cur)) return;
    f32x4 acc[2][2][4][2];
#pragma unroll
    for (int a = 0; a < 2; ++a)
#pragma unroll
        for (int b = 0; b < 2; ++b)
#pragma unroll
            for (int m = 0; m < 4; ++m)
#pragma unroll
                for (int n = 0; n < 2; ++n) acc[a][b][m][n] = (f32x4){0.f, 0.f, 0.f, 0.f};
    bf16x8 At[4][2], B0[2][2], B1[2][2];
    const char* cA = (const char*)g.A + (size_t)cur.pm * tstep; const char* cB = (const char*)g.Bt + (size_t)cur.pn * tstep;
    S.a_ready(cur);
    if constexpr (SP2) {
        PG8_STAGE(PG8_SB(0, 0), cB, voffB); PG8_STAGE(PG8_SB(0, 1), cB + hstep, voffB); PG8_STAGE(PG8_SA(0, 0), cA, voffA); PG8_STAGE(PG8_SA(0, 1), cA + hstep, voffA);
        if (wr == 1) PG8_BAR;
        PG8_WAIT_V(2); PG8_BAR;
        PG8_STAGE(PG8_SB(1, 0), cB + kstep, voffB); PG8_STAGE(PG8_SA(1, 0), cA + kstep, voffA); PG8_STAGE(PG8_SB(1, 1), cB + hstep + kstep, voffB);
        PG8_WAIT_V(6); PG8_BAR;
    } else {
        PG8_STAGE(PG8_SB(0, 0), cB, voffB); PG8_STAGE(PG8_SA(0, 0), cA, voffA); PG8_STAGE(PG8_SB(0, 1), cB + hstep, voffB); PG8_STAGE(PG8_SA(0, 1), cA + hstep, voffA);
        if (wr == 1) PG8_BAR;
        PG8_WAIT_V(4); PG8_BAR;
        PG8_STAGE(PG8_SB(1, 0), cB + kstep, voffB); PG8_STAGE(PG8_SA(1, 0), cA + kstep, voffA); PG8_STAGE(PG8_SB(1, 1), cB + hstep + kstep, voffB);
        PG8_WAIT_V(6); PG8_BAR;
    }
    for (;;) {
        const bool has_next = S.next(ui + 1, nxt);
        const char* nA = has_next ? (const char*)g.A + (size_t)nxt.pm * tstep : cA; const char* nB = has_next ? (const char*)g.Bt + (size_t)nxt.pn * tstep : cB;
        for (int t = 0; t < nt; t += 2) {
            const bool last = (t == nt - 2);
            const char* a1 = cA + (size_t)(t + 1) * kstep;
            const char* a2 = last ? nA : cA + (size_t)(t + 2) * kstep; const char* b2 = last ? nB : cB + (size_t)(t + 2) * kstep;
            const char* a3 = a2 + kstep; const char* b3 = b2 + kstep;
            if (last && has_next) S.a_ready(nxt);
            if constexpr (SP2) {
            PG8_LDB(B0, 0, 0); PG8_LDB(B1, 0, 1); PG8_SCHED; PG8_LDA(At, 0, 0); PG8_STAGE(PG8_SA(1, 1), a1 + hstep, voffA);
            PG8_WAIT_V(8); PG8_WAIT_L(0); PG8_BAR; PG8_MMA(0, 0, At, B0); PG8_MMA(0, 1, At, B1); PG8_BAR; PG8_SCHED;
            PG8_LDA(At, 0, 1); PG8_STAGE(PG8_SB(0, 0), b2, voffB); PG8_STAGE(PG8_SB(0, 1), b2 + hstep, voffB); PG8_STAGE(PG8_SA(0, 0), a2, voffA);
            PG8_WAIT_V(8); PG8_WAIT_L(0); PG8_BAR; PG8_MMA(1, 0, At, B0); PG8_MMA(1, 1, At, B1); PG8_BAR; PG8_SCHED;
            PG8_LDB(B0, 1, 0); PG8_LDB(B1, 1, 1); PG8_SCHED; PG8_LDA(At, 1, 0); PG8_STAGE(PG8_SA(0, 1), a2 + hstep, voffA);
            PG8_WAIT_V(8); PG8_WAIT_L(0); PG8_BAR; PG8_MMA(0, 0, At, B0); PG8_MMA(0, 1, At, B1); PG8_BAR; PG8_SCHED;
            PG8_LDA(At, 1, 1); PG8_STAGE(PG8_SB(1, 0), b3, voffB); PG8_STAGE(PG8_SB(1, 1), b3 + hstep, voffB); PG8_STAGE(PG8_SA(1, 0), a3, voffA);
            PG8_WAIT_V(8); PG8_WAIT_L(0); PG8_BAR; PG8_MMA(1, 0, At, B0); PG8_MMA(1, 1, At, B1); PG8_BAR; PG8_SCHED;
            } else {
            PG8_LDB(B0, 0, 0); PG8_SCHED; PG8_LDA(At, 0, 0); PG8_STAGE(PG8_SA(1, 1), a1 + hstep, voffA);
            PG8_WAIT_L(8); PG8_BAR; PG8_WAIT_L(0); PG8_MMA(0, 0, At, B0); PG8_BAR; PG8_SCHED;
            PG8_LDB(B1, 0, 1); PG8_STAGE(PG8_SB(0, 0), b2, voffB);
            PG8_BAR; PG8_WAIT_L(0); PG8_MMA(0, 1, At, B1); PG8_BAR;
            PG8_LDA(At, 0, 1); PG8_STAGE(PG8_SA(0, 0), a2, voffA);
            PG8_BAR; PG8_WAIT_L(0); PG8_MMA(1, 0, At, B0); PG8_BAR; PG8_SCHED;
            PG8_STAGE(PG8_SB(0, 1), b2 + hstep, voffB);
            PG8_WAIT_V(6); PG8_BAR; PG8_MMA(1, 1, At, B1); PG8_BAR;
            PG8_LDB(B0, 1, 0); PG8_SCHED; PG8_LDA(At, 1, 0); PG8_STAGE(PG8_SA(0, 1), a2 + hstep, voffA);
            PG8_WAIT_L(8); PG8_BAR; PG8_WAIT_L(0); PG8_MMA(0, 0, At, B0); PG8_BAR; PG8_SCHED;
            PG8_LDB(B1, 1, 1); PG8_STAGE(PG8_SB(1, 0), b3, voffB);
            PG8_BAR; PG8_WAIT_L(0); PG8_MMA(0, 1, At, B1); PG8_BAR;
            PG8_LDA(At, 1, 1); PG8_STAGE(PG8_SA(1, 0), a3, voffA);
            PG8_BAR; PG8_WAIT_L(0); PG8_MMA(1, 0, At, B0); PG8_BAR; PG8_SCHED;
            PG8_STAGE(PG8_SB(1, 1), b3 + hstep, voffB);
            PG8_WAIT_V(6); PG8_BAR; PG8_MMA(1, 1, At, B1); PG8_BAR;
            }
        }
        if constexpr (ALIGN_EPI) { if (wr == 0) PG8_BAR; }
        if constexpr (!Epi::AFTER_DRAIN) { E(acc, cur, wr, wc, fr, fq); S.done(cur); }
        if (!has_next) break;
#pragma unroll
        for (int a = 0; a < 2; ++a)
#pragma unroll
            for (int b = 0; b < 2; ++b)
#pragma unroll
                for (int m = 0; m < 4; ++m)
#pragma unroll
                    for (int n = 0; n < 2; ++n) acc[a][b][m][n] = (f32x4){0.f, 0.f, 0.f, 0.f};
        cur = nxt; cA = nA; cB = nB; ++ui;
        if constexpr (ALIGN_EPI) { if (wr == 1) PG8_BAR; }
    }
    PG8_WAIT_V(0);
    if constexpr (!ALIGN_EPI) { if (wr == 0) PG8_BAR; }
    PG8_BAR;
    if constexpr (Epi::AFTER_DRAIN) { E.fused(acc, cur, wr, wc, fr, fq, lds, wid, lane); S.done(cur); }
#undef PG8_SA
#undef PG8_SB
#undef PG8_STAGE
#undef PG8_LDA
#undef PG8_LDB
#undef PG8_MMA
#undef PG8_WAIT_V
#undef PG8_WAIT_L
#undef PG8_BAR
#undef PG8_SCHED
}
}

#ifndef PG8_SP2
#define PG8_SP2 true
#endif
#ifndef PG8_ALIGN
#define PG8_ALIGN true
#endif
namespace attn_body {
using bf16=__hip_bfloat16;
using bf16x8=__attribute__((ext_vector_type(8)))short;
using s16x4=__attribute__((ext_vector_type(4)))short;
using f32x16=__attribute__((ext_vector_type(16)))float;
using u32x4=__attribute__((ext_vector_type(4)))unsigned;
constexpr int D=64;
constexpr int NW=8,QBLK=32,QB=QBLK*NW,KVBLK=64;
__device__ __forceinline__ int crow(int r,int hi){return (r&3)+8*(r>>2)+4*hi;}
#define SBAR() __builtin_amdgcn_sched_barrier(0)
__device__ __forceinline__ void cmask(f32x16&p0,f32x16&p1,int jb,int qrel,int hi){
  const float NEG=-INFINITY; int kb=64*jb+4*hi;
  #pragma unroll
  for(int r=0;r<16;++r){int kv=kb+(r&3)+8*(r>>2); if(kv>qrel)p0[r]=NEG; if(kv+32>qrel)p1[r]=NEG;}
}

constexpr int NSLOT=3, SLOTB=8192;
constexpr int LDS_K=0, LDS_V=NSLOT*SLOTB, LDS_WS=2*NSLOT*SLOTB, LDS_OST=LDS_WS+NW*64*4, LDS_BYTES=LDS_OST+NW*8192;
constexpr float C2=0.125f*1.4426950408889634f;
__device__ __forceinline__ void glds16(const void*gsrc,unsigned lds_dst){unsigned keep;
  asm volatile("s_mov_b32 %0, m0\n\ts_mov_b32 m0, %2\n\ts_nop 0\n\tglobal_load_lds_dwordx4 %1, off\n\ts_mov_b32 m0, %0":"=&s"(keep):"v"(gsrc),"s"(lds_dst):"memory");}
__device__ __forceinline__ float max3f(float a,float b,float c){float r;asm("v_max3_f32 %0, %1, %2, %3":"=v"(r):"v"(a),"v"(b),"v"(c));return r;}
__device__ __forceinline__ float max2f(float a,float b){float r;asm("v_max_f32_e32 %0, %1, %2":"=v"(r):"v"(a),"v"(b));return r;}
__device__ __forceinline__ float fadd_s(float a,float b){float r;asm("v_add_f32_e32 %0, %1, %2":"=v"(r):"v"(a),"v"(b));return r;}
__device__ __forceinline__ float fsub_s(float a,float b){float r;asm("v_sub_f32_e32 %0, %1, %2":"=v"(r):"v"(a),"v"(b));return r;}
typedef float f32x2_t __attribute__((ext_vector_type(2))); typedef __bf16 bf16x2_t __attribute__((ext_vector_type(2)));
__device__ __forceinline__ unsigned cvtpk_s(float lo,float hi){f32x2_t v={lo,hi};bf16x2_t b=__builtin_convertvector(v,bf16x2_t);return __builtin_bit_cast(unsigned,b);}
#define WAIT_BAR(N) asm volatile("s_waitcnt vmcnt(" #N ") lgkmcnt(0)\n\ts_barrier":::"memory")

__device__ __forceinline__ void qkt(f32x16&p0,f32x16&p1,const char*Kslot,const bf16x8*qr,const f32x16&negm,int r32,int hi){
  const char*kb=Kslot+hi*1024+r32*16;
  #pragma unroll
  for(int d0=0;d0<4;++d0){
    const bf16x8 b0=*reinterpret_cast<const bf16x8*>(kb+d0*2048);
    const bf16x8 b1=*reinterpret_cast<const bf16x8*>(kb+d0*2048+512);
    if(d0==0){p0=__builtin_amdgcn_mfma_f32_32x32x16_bf16(b0,qr[0],negm,0,0,0);p1=__builtin_amdgcn_mfma_f32_32x32x16_bf16(b1,qr[0],negm,0,0,0);}
    else{p0=__builtin_amdgcn_mfma_f32_32x32x16_bf16(b0,qr[d0],p0,0,0,0);p1=__builtin_amdgcn_mfma_f32_32x32x16_bf16(b1,qr[d0],p1,0,0,0);}}
}
typedef __attribute__((address_space(3))) const char* lds_cptr;
typedef short v4i16_t __attribute__((ext_vector_type(4)));
__device__ __forceinline__ void kload8(bf16x8*kf,lds_cptr kp){
  kf[0]=*(const __attribute__((address_space(3))) bf16x8*)(kp);      kf[1]=*(const __attribute__((address_space(3))) bf16x8*)(kp+512);
  kf[2]=*(const __attribute__((address_space(3))) bf16x8*)(kp+2048); kf[3]=*(const __attribute__((address_space(3))) bf16x8*)(kp+2560);
  kf[4]=*(const __attribute__((address_space(3))) bf16x8*)(kp+4096); kf[5]=*(const __attribute__((address_space(3))) bf16x8*)(kp+4608);
  kf[6]=*(const __attribute__((address_space(3))) bf16x8*)(kp+6144); kf[7]=*(const __attribute__((address_space(3))) bf16x8*)(kp+6656);
}
__device__ __forceinline__ void kload2(bf16x8*kf,lds_cptr kp,int j){ kf[2*j]=*(const __attribute__((address_space(3))) bf16x8*)(kp+j*2048); kf[2*j+1]=*(const __attribute__((address_space(3))) bf16x8*)(kp+j*2048+512); }
__device__ __forceinline__ s16x4 vtr(lds_cptr p){ return __builtin_bit_cast(s16x4,__builtin_amdgcn_ds_read_tr16_b64_v4i16((__attribute__((address_space(3))) v4i16_t*)p)); }
__device__ __forceinline__ float rowmax(const f32x16&p0,const f32x16&p1){
  float a=max3f(p0[0],p0[1],p1[0]),b=max3f(p0[2],p0[3],p1[1]);a=max3f(a,p1[2],p1[3]);
  #pragma unroll
  for(int r=4;r<16;r+=4){a=max3f(a,p0[r],p0[r+1]);b=max3f(b,p0[r+2],p0[r+3]);a=max3f(a,p1[r],p1[r+1]);b=max3f(b,p1[r+2],p1[r+3]);}
  const float m=max2f(a,b);
  auto rr=__builtin_amdgcn_permlane32_swap(__float_as_uint(m),__float_as_uint(m),false,false);
  return max2f(__uint_as_float(rr[0]),__uint_as_float(rr[1]));
}
__device__ __forceinline__ void pv(f32x16*o,int vb,bf16x8 pa0,bf16x8 pa1,bf16x8 pa2,bf16x8 pa3){
  #pragma unroll
  for(int d0=0;d0<2;++d0){s16x4 lo[4],hi[4];
    #pragma unroll
    for(int ks=0;ks<4;++ks){
      asm volatile("ds_read_b64_tr_b16 %0,%1 offset:%c2":"=&v"(lo[ks]):"v"(vb),"i"(d0*4096+ks*1024):"memory");
      asm volatile("ds_read_b64_tr_b16 %0,%1 offset:%c2":"=&v"(hi[ks]):"v"(vb),"i"(d0*4096+ks*1024+512):"memory");}
    asm volatile("s_waitcnt lgkmcnt(0)":::"memory");SBAR();
    #define PK(k) (bf16x8){lo[k][0],lo[k][1],lo[k][2],lo[k][3],hi[k][0],hi[k][1],hi[k][2],hi[k][3]}
    o[d0]=__builtin_amdgcn_mfma_f32_32x32x16_bf16(pa0,PK(0),o[d0],0,0,0);
    o[d0]=__builtin_amdgcn_mfma_f32_32x32x16_bf16(pa1,PK(1),o[d0],0,0,0);
    o[d0]=__builtin_amdgcn_mfma_f32_32x32x16_bf16(pa2,PK(2),o[d0],0,0,0);
    o[d0]=__builtin_amdgcn_mfma_f32_32x32x16_bf16(pa3,PK(3),o[d0],0,0,0);
    #undef PK
  }
}

#ifndef ATTN_STORE16
#define ATTN_STORE16(p,v) (*(u32x4*)(p)=(v))
#endif
template<int THRL,int QP,int KP> __device__ __forceinline__ void attn_pass(const bf16*Qblk,const bf16*__restrict__ Kh,const bf16*__restrict__ Vh,int NT,bf16*Odst,int ecol,float lam,int MODE,char*shm){
  const int tid=threadIdx.x,lane=tid&63,r32=lane&31,hi=lane>>5; const int wid=__builtin_amdgcn_readfirstlane(tid>>6);
  const bf16*Qw=Qblk+(long)(wid*QBLK)*QP;
  const unsigned lds0=(unsigned)(uintptr_t)shm;
  float*wsf=(float*)(shm+LDS_WS)+wid*64;
  const bf16*ksrc=Kh+(long)lane*KP+wid*8;
  const bf16*vsrc=Vh+(long)(16*(wid&3)+(lane>>2))*KP+(wid>>2)*32+(lane&3)*8;
  const unsigned kdst=lds0+LDS_K+wid*1024, vdst=lds0+LDS_V+wid*1024;
  #define DMA_K(t,slot) glds16(ksrc+(long)(t)*KVBLK*KP,(unsigned)__builtin_amdgcn_readfirstlane(kdst+(slot)))
  #define DMA_V(t,slot) glds16(vsrc+(long)(t)*KVBLK*KP,(unsigned)__builtin_amdgcn_readfirstlane(vdst+(slot)))
  const int vb0=(int)(lds0+LDS_V)+((lane>>4)&1)*32+(lane&3)*8+(4*hi+((lane&15)>>2))*64;
  const char*Kbase=shm+LDS_K; bf16x8 kf[8];
  const lds_cptr shm3=(lds_cptr)shm; const lds_cptr kp0=shm3+LDS_K+hi*1024+r32*16; const lds_cptr vp0=shm3+LDS_V+((lane>>4)&1)*32+(lane&3)*8+(4*hi+((lane&15)>>2))*64;
  DMA_K(0,0);DMA_V(0,0);DMA_K(1,SLOTB);
  bf16x8 qr[4];
  #pragma unroll
  for(int d0=0;d0<4;++d0)qr[d0]=*reinterpret_cast<const bf16x8*>(&Qw[(long)r32*QP+d0*16+hi*8]);
  float mhat=0.f,l_reg=0.f;f32x16 o[2];o[0]=f32x16{};o[1]=f32x16{};const f32x16 negm=f32x16{};
  #define CMASK(P0,P1,t) do{}while(0)
  bool resc=false;
  #define START(P0,P1) do{ const float rm=rowmax(P0,P1); resc=false; \
    { const float dl=rm; mhat=fadd_s(mhat,dl); \
      _Pragma("unroll") for(int r=0;r<16;++r){P0[r]=fsub_s(P0[r],dl);P1[r]=fsub_s(P1[r],dl);} \
      } \
    _Pragma("unroll") for(int r=0;r<16;++r)P0[r]=__builtin_amdgcn_exp2f(P0[r]); }while(0)
  #define RESC() do{ if(resc){ asm volatile("s_waitcnt lgkmcnt(0)":::"memory"); \
      _Pragma("unroll") for(int d_=0;d_<2;++d_) _Pragma("unroll") for(int r=0;r<16;++r)o[d_][r]*=wsf[crow(r,hi)]; } }while(0)
  f32x16 pA0,pA1,pB0,pB1;
  int sl_prev=0,sl_cur=0,sl_next=SLOTB;
  #define ROT() do{sl_prev=sl_cur;sl_cur=sl_next;sl_next=(sl_next==(NSLOT-1)*SLOTB)?0:sl_next+SLOTB;}while(0)
  DMA_K(2,2*SLOTB);
  WAIT_BAR(3);
  qkt(pA0,pA1,Kbase,qr,negm,r32,hi);asm volatile("s_nop 15\n\ts_nop 7":"+v"(pA0),"+v"(pA1));CMASK(pA0,pA1,0);
  START(pA0,pA1);
  _Pragma("unroll") for(int r=0;r<16;++r)pA1[r]=__builtin_amdgcn_exp2f(pA1[r]);
  WAIT_BAR(0);
  DMA_K(3,0);DMA_V(1,SLOTB);
  ROT();
  kload8(kf,kp0+sl_cur);
  WAIT_BAR(2);
  s16x4 vlo[8],vhi[8]; u32x4 pw0,pw1,pw2,pw3;
  #define PKW(P,B) cvtpk_s(P[B],P[B+1])
  #define PAF(k) __builtin_bit_cast(bf16x8,pw##k)
  #define VFR(i) (bf16x8){vlo[i][0],vlo[i][1],vlo[i][2],vlo[i][3],vhi[i][0],vhi[i][1],vhi[i][2],vhi[i][3]}
  #define PIN(x) asm volatile("":"+v"(x))
  #define MX3(a,b,c) __builtin_fmaxf(__builtin_fmaxf((a),(b)),(c))
  #define GAPA(MF,A0,A1,A2,A3,W0,W1,PW) do{ MF; sacc+=A0; sacc+=A1; sacc+=A2; sacc+=A3; PIN(sacc); W0; W1; PIN(PW); SBAR(); }while(0)
  #define EX(v) __builtin_amdgcn_exp2f(v)
  #define GAPB(MF,X,B) do{ MF; X[B]=EX(X[B]); X[B+1]=EX(X[B+1]); X[B+2]=EX(X[B+2]); X[B+3]=EX(X[B+3]); PIN(X); SBAR(); }while(0)
  #define VRD(i) do{ vlo[i]=vtr(vp_+(((i)>>2)*4096+((i)&3)*1024)); vhi[i]=vtr(vp_+(((i)>>2)*4096+((i)&3)*1024+512)); }while(0)
  #define KRD(G,j) do{ if(G){ kload2(kf,kp0+sl_next,j); SBAR(); } }while(0)
  #define STEP(C0,C1,P0,P1,t,GK,GV,GL) do{ SBAR(); \
    const lds_cptr vp_=vp0+sl_prev; \
    VRD(0); SBAR(); float sacc=(P0[0]+P0[1]); \
    GAPA(C0=__builtin_amdgcn_mfma_f32_32x32x16_bf16(kf[0],qr[0],negm,0,0,0), P0[2],P0[3],P0[4],P0[5],     pw0[0]=PKW(P0,0), pw0[1]=PKW(P0,2), pw0); \
    VRD(4); SBAR(); GAPA(C1=__builtin_amdgcn_mfma_f32_32x32x16_bf16(kf[1],qr[0],negm,0,0,0), P0[6],P0[7],P0[8],P0[9],     pw0[2]=PKW(P0,4), pw0[3]=PKW(P0,6), pw0); \
    VRD(1); SBAR(); GAPA(C0=__builtin_amdgcn_mfma_f32_32x32x16_bf16(kf[2],qr[1],C0,0,0,0),   P0[10],P0[11],P0[12],P0[13], pw1[0]=PKW(P0,8), pw1[1]=PKW(P0,10), pw1); \
    VRD(5); SBAR(); GAPA(C1=__builtin_amdgcn_mfma_f32_32x32x16_bf16(kf[3],qr[1],C1,0,0,0),   P0[14],P0[15],P1[0],P1[1],   pw1[2]=PKW(P0,12),pw1[3]=PKW(P0,14), pw1); \
    VRD(2); SBAR(); GAPA(C0=__builtin_amdgcn_mfma_f32_32x32x16_bf16(kf[4],qr[2],C0,0,0,0),   P1[2],P1[3],P1[4],P1[5],     pw2[0]=PKW(P1,0), pw2[1]=PKW(P1,2), pw2); \
    VRD(6); SBAR(); GAPA(C1=__builtin_amdgcn_mfma_f32_32x32x16_bf16(kf[5],qr[2],C1,0,0,0),   P1[6],P1[7],P1[8],P1[9],     pw2[2]=PKW(P1,4), pw2[3]=PKW(P1,6), pw2); \
    VRD(3); SBAR(); GAPA(C0=__builtin_amdgcn_mfma_f32_32x32x16_bf16(kf[6],qr[3],C0,0,0,0),   P1[10],P1[11],P1[12],P1[13], pw3[0]=PKW(P1,8), pw3[1]=PKW(P1,10), pw3); \
    VRD(7); SBAR(); GAPA(C1=__builtin_amdgcn_mfma_f32_32x32x16_bf16(kf[7],qr[3],C1,0,0,0),   P1[14],P1[15],0.f,0.f,       pw3[2]=PKW(P1,12),pw3[3]=PKW(P1,14), pw3); \
    l_reg+=sacc; \
    if(GK){DMA_K((t)+3,sl_cur);} if(GV){DMA_V((t)+1,sl_next);} \
    _Pragma("unroll") for(int r=0;r<16;++r){C0[r]-=mhat;C1[r]-=mhat;} \
    { float a=MX3(C0[0],C0[1],C1[0]),b=MX3(C0[2],C0[3],C1[1]); a=MX3(a,C1[2],C1[3]); \
      _Pragma("unroll") for(int r=4;r<16;r+=4){a=MX3(a,C0[r],C0[r+1]);b=MX3(b,C0[r+2],C0[r+3]);a=MX3(a,C1[r],C1[r+1]);b=MX3(b,C1[r+2],C1[r+3]);} \
      float rm=__builtin_fmaxf(a,b); { auto rr=__builtin_amdgcn_permlane32_swap(__float_as_uint(rm),__float_as_uint(rm),false,false); rm=__builtin_fmaxf(__uint_as_float(rr[0]),__uint_as_float(rr[1])); } \
      resc=false; \
      if(__builtin_expect(__any(rm>(float)THRL),0)){ const float dl=__builtin_fmaxf(rm,0.f); mhat+=dl; \
        _Pragma("unroll") for(int r=0;r<16;++r){C0[r]-=dl;C1[r]-=dl;} \
        const float f=__builtin_amdgcn_exp2f(-dl); l_reg*=f; if(hi==0)wsf[r32]=f; resc=true; } } \
    SBAR(); \
    GAPB(o[0]=__builtin_amdgcn_mfma_f32_32x32x16_bf16(PAF(0),VFR(0),o[0],0,0,0), C0,0); \
    GAPB(o[1]=__builtin_amdgcn_mfma_f32_32x32x16_bf16(PAF(0),VFR(4),o[1],0,0,0), C0,4); \
    KRD(GL,0); GAPB(o[0]=__builtin_amdgcn_mfma_f32_32x32x16_bf16(PAF(1),VFR(1),o[0],0,0,0), C0,8); \
    KRD(GL,1); GAPB(o[1]=__builtin_amdgcn_mfma_f32_32x32x16_bf16(PAF(1),VFR(5),o[1],0,0,0), C0,12); \
    KRD(GL,2); GAPB(o[0]=__builtin_amdgcn_mfma_f32_32x32x16_bf16(PAF(2),VFR(2),o[0],0,0,0), C1,0); \
    KRD(GL,3); GAPB(o[1]=__builtin_amdgcn_mfma_f32_32x32x16_bf16(PAF(2),VFR(6),o[1],0,0,0), C1,4); \
    GAPB(o[0]=__builtin_amdgcn_mfma_f32_32x32x16_bf16(PAF(3),VFR(3),o[0],0,0,0), C1,8); \
    GAPB(o[1]=__builtin_amdgcn_mfma_f32_32x32x16_bf16(PAF(3),VFR(7),o[1],0,0,0), C1,12); \
    }while(0)
  int t=1;
  #undef CMASK
  #define CMASK(P0,P1,t) do{}while(0)
  for(;t+5<NT;t+=2){
    STEP(pB0,pB1,pA0,pA1,t,true,true,true);     WAIT_BAR(2); RESC(); ROT();
    STEP(pA0,pA1,pB0,pB1,t+1,true,true,true);   WAIT_BAR(2); RESC(); ROT();
  }
  #undef CMASK
  #define CMASK(P0,P1,t) do{}while(0)
  #define ENDW(tt) do{ if((tt)+3<NT){WAIT_BAR(2);} else if((tt)+2<NT){WAIT_BAR(1);} else {WAIT_BAR(0);} }while(0)
  for(;t+1<NT;t+=2){
    STEP(pB0,pB1,pA0,pA1,t,(t+3<NT),(t+1<NT),(t+1<NT));       ENDW(t);   RESC(); ROT();
    STEP(pA0,pA1,pB0,pB1,t+1,(t+4<NT),(t+2<NT),(t+2<NT));     ENDW(t+1); RESC(); ROT();
  }
  STEP(pB0,pB1,pA0,pA1,NT-1,false,false,false); RESC();
  { float sacc=pB0[0]+pB0[1]; _Pragma("unroll") for(int r=2;r<16;++r)sacc+=pB0[r]; _Pragma("unroll") for(int r=0;r<16;++r)sacc+=pB1[r]; l_reg+=sacc;
    pw0=(u32x4){PKW(pB0,0),PKW(pB0,2),PKW(pB0,4),PKW(pB0,6)};pw1=(u32x4){PKW(pB0,8),PKW(pB0,10),PKW(pB0,12),PKW(pB0,14)};pw2=(u32x4){PKW(pB1,0),PKW(pB1,2),PKW(pB1,4),PKW(pB1,6)};pw3=(u32x4){PKW(pB1,8),PKW(pB1,10),PKW(pB1,12),PKW(pB1,14)};
    SBAR(); pv(o,vb0+sl_cur,PAF(0),PAF(1),PAF(2),PAF(3)); }
  #undef PKW
  #undef PAF
  #undef VFR
  #undef PIN
  #undef MX3
  #undef GAPA
  #undef GAPB
  #undef EX
  #undef VRD
  #undef KRD
  #undef STEP
  #undef ENDW
  { int lane_e=lane; asm volatile("":"+v"(lane_e)); const int r32=lane_e&31,hi=lane_e>>5,lane=lane_e;
  {auto rr=__builtin_amdgcn_permlane32_swap(__float_as_uint(l_reg),__float_as_uint(l_reg),false,false);l_reg=__uint_as_float(rr[0])+__uint_as_float(rr[1]);}
  if(hi==0)wsf[32+r32]=l_reg;asm volatile("s_waitcnt lgkmcnt(0)":::"memory");
  float rli[16];
  #pragma unroll
  for(int r=0;r<16;++r)rli[r]=__builtin_amdgcn_rcpf(wsf[32+crow(r,hi)]);
  if(MODE==0){
    bf16*Ow=Odst+(long)(wid*QBLK)*1024;
    bf16*stg=(bf16*)(shm+LDS_OST)+wid*4096;
    #pragma unroll
    for(int r=0;r<16;++r){const int orow=crow(r,hi);
      #pragma unroll
      for(int d0=0;d0<2;++d0)stg[orow*64+d0*32+r32]=__float2bfloat16(o[d0][r]*rli[r]);}
    asm volatile("s_waitcnt lgkmcnt(0)":::"memory");
    #pragma unroll
    for(int i=0;i<4;++i){const int row=i*8+(lane>>3),ch=lane&7; const u32x4 v=*(const u32x4*)(stg+row*64+ch*8); ATTN_STORE16(Ow+(long)row*1024+ch*8,v);}
  } else {
    bf16*stg=(bf16*)(shm+LDS_OST)+wid*4096+ecol;
    #pragma unroll
    for(int r=0;r<16;++r){const int orow=crow(r,hi);
      #pragma unroll
      for(int d0=0;d0<2;++d0){ float val=o[d0][r]*rli[r];
        if(MODE==2){ val=__bfloat162float(stg[orow*128+d0*32+r32])-lam*val; }
        stg[orow*128+d0*32+r32]=__float2bfloat16(val);} }
  }
  }
  asm volatile("s_waitcnt lgkmcnt(0)\n\ts_barrier":::"memory");
  #undef DMA_K
  #undef DMA_V
  #undef CMASK
  #undef START
  #undef RESC
  #undef ROT
}
constexpr int ATTN_LDS_BYTES=LDS_BYTES;

struct AttnArgs { const bf16* QB; const bf16* KB; const bf16* VB; bf16* OB; const float* subln; float lam; };
template<int THRL> __device__ __forceinline__ void attn_unit(const AttnArgs&A,int qrow0,int krow0,int NT,int isdiff,int head,char*shm){
  const int tid=threadIdx.x,lane=tid&63; const int wid=__builtin_amdgcn_readfirstlane(tid>>6);
  const int qcol=isdiff?head*128:512+head*64, kcol=isdiff?head*128:512+(head>>2)*64;
  const bf16*Qb=A.QB+(long)qrow0*1024+qcol; const bf16*Kb=A.KB+(long)krow0*640+kcol; const bf16*Vb=A.VB+(long)krow0*640+kcol;
  bf16*Ob=A.OB+(long)qrow0*1024+qcol;
  const int npass=isdiff?4:1;
  for(int ps=0;ps<npass;++ps){
    const int mp=ps&1,e=ps>>1; const int mode=isdiff?1+mp:0;
    attn_pass<THRL,1024,640>(Qb+mp*64,Kb+mp*64,Vb+e*64,NT,Ob,e*64,A.lam,mode,shm);
  }
  if(isdiff){
    int lane_e=lane; asm volatile("":"+v"(lane_e));
    const bf16*stg=(const bf16*)(shm+LDS_OST)+wid*4096; bf16*Ow=Ob+(long)(wid*QBLK)*1024; const int ch=lane_e&15;
    float g[8];
    #pragma unroll
    for(int k=0;k<8;++k)g[k]=A.subln[ch*8+k]*0.8f;
    #pragma unroll
    for(int i=0;i<8;++i){ const int row=i*4+(lane_e>>4); const u32x4 v=*(const u32x4*)(stg+row*128+ch*8);
      float f[8];
      #pragma unroll
      for(int k=0;k<4;++k){f[2*k]=__uint_as_float(v[k]<<16);f[2*k+1]=__uint_as_float(v[k]&0xffff0000u);}
      float ss=0.f;
      #pragma unroll
      for(int k=0;k<8;++k)ss+=f[k]*f[k];
      ss+=__shfl_xor(ss,1);ss+=__shfl_xor(ss,2);ss+=__shfl_xor(ss,4);ss+=__shfl_xor(ss,8);
      const float rs=1.0f/sqrtf(ss*(1.0f/128.0f)+1e-6f);
      u32x4 w; w.x=cvtpk_s(f[0]*rs*g[0],f[1]*rs*g[1]); w.y=cvtpk_s(f[2]*rs*g[2],f[3]*rs*g[3]); w.z=cvtpk_s(f[4]*rs*g[4],f[5]*rs*g[5]); w.w=cvtpk_s(f[6]*rs*g[6],f[7]*rs*g[7]);
      *(u32x4*)(Ow+(long)row*1024+ch*8)=w; }
    asm volatile("s_waitcnt lgkmcnt(0)":::"memory");
  }
}
template<int THRL=8> __device__ __forceinline__ void attn_phase(char*lds,const AttnArgs&A,int vcu,int G){
  for(int s=vcu;s<1280;s+=G){
    const int j=s>>8,r=s&255; int qrow0,krow0,NT,isdiff,head;
    if(j==0){ qrow0=8192+(r>>6)*4096+(r&15)*256; krow0=8192+(r>>6)*4608; NT=72; isdiff=1; head=(r>>4)&3; }
    else if(j<=2){ const int u=2*r+(j-1); qrow0=8192+(u>>7)*4096+(u&15)*256; krow0=8192+(u>>7)*4608; NT=72; isdiff=0; head=(u>>4)&7; }
    else if(j==3){ if(r>=128)continue; qrow0=(r>>2)*256; krow0=qrow0; NT=4; isdiff=1; head=r&3; }
    else { qrow0=(r>>3)*256; krow0=qrow0; NT=4; isdiff=0; head=r&7; }
    attn_unit<THRL>(A,qrow0,krow0,NT,isdiff,head,lds);
  }
}
#undef SBAR
#undef WAIT_BAR
}
#define GAS __attribute__((address_space(1)))
#define LAS __attribute__((address_space(3)))
typedef unsigned short bfu;
typedef unsigned v4u __attribute__((ext_vector_type(4)));
typedef unsigned v2u __attribute__((ext_vector_type(2)));
typedef float f32x4 __attribute__((ext_vector_type(4)));
#define LDS_WAIT() asm volatile("s_waitcnt lgkmcnt(0)" ::: "memory")
constexpr int NWAVES = 8, LDS_BYTES = 147456;
constexpr size_t MiB = 1u << 20;
constexpr size_t WS_MOD = 0, WS_ROPE = 256 * 1024, WS_WGU1 = 1 * MiB, WS_WD1 = 12 * MiB, WS_WIN = 18 * MiB, WS_WOUT = 23 * MiB, WS_WGU2 = 25 * MiB, WS_WD2 = 36 * MiB;
constexpr size_t WS_H = 42 * MiB, WS_ACT = 90 * MiB, WS_QB = 90 * MiB, WS_KB = 138 * MiB, WS_VB = 171 * MiB, WS_END = 222 * MiB;
constexpr int M_TOK = 24576, D_M = 1024, D_FF = 2816, D_IN = 2304, KVROWS = 26624, NMODV_ = 9216;
static_assert(WS_KB + (size_t)KVROWS * 640 * 2 <= WS_VB && WS_VB + (size_t)KVROWS * 640 * 2 <= WS_END && WS_ACT + (size_t)M_TOK * D_FF * 2 <= WS_END, "ws map");
static_assert(attn_body::ATTN_LDS_BYTES <= 131072, "attention LDS");

__device__ __forceinline__ unsigned pk2(float lo, float hi) { return pg8::cvt_pk_bf16(lo, hi); }
__device__ __forceinline__ float wave_sum(float v) {
#pragma unroll
    for (int o = 1; o < 64; o <<= 1) v += __shfl_xor(v, o);
    return v;
}
__device__ __forceinline__ void transpose_item(const float* W, int K, int N, bfu* WT, int kind, LAS float* scr, int item, int lane) {
    const int nblk = N / 32, kb = item / nblk, nb = item % nblk, k0 = 64 * kb, n0 = 32 * nb;
    int pr = n0;
    if (kind == 1) { const int L = n0 < D_FF ? n0 : n0 - D_FF; pr = 256 * (L / 128) + (L % 128) + (n0 < D_FF ? 0 : 128); }
    else if (kind == 2) { const int ch = n0 / 64, half = (n0 / 32) & 1; pr = 256 * (ch / 4) + 128 * half + 32 * (ch % 4); }
#pragma unroll 8
    for (int i = 0; i < 32; ++i) { const int kk = 2 * i + (lane >> 5); scr[kk * 33 + (lane & 31)] = W[(size_t)(k0 + kk) * N + n0 + (lane & 31)]; }
    LDS_WAIT(); asm volatile("" ::: "memory");
    const int c = lane & 7;
#pragma unroll
    for (int j = 0; j < 4; ++j) { const int n = (lane >> 3) + 8 * j; const LAS float* s = scr + (8 * c) * 33 + n;
        v4u o; o.x = pk2(s[0 * 33], s[1 * 33]); o.y = pk2(s[2 * 33], s[3 * 33]); o.z = pk2(s[4 * 33], s[5 * 33]); o.w = pk2(s[6 * 33], s[7 * 33]);
        *(GAS v4u*)(WT + (size_t)(pr + n) * K + k0 + 8 * c) = o; }
    LDS_WAIT(); asm volatile("" ::: "memory");
}
__device__ __forceinline__ void ada_item(const float* c, const float* c_ctx, const float* w_ada, const float* b_ada, float* mod, LAS float* scr, int item, int lane) {
    const int cb = item % 144, kc = item / 144, n = cb * 64 + lane, k0 = kc * 128;
#pragma unroll
    for (int i = 0; i < 10; ++i) { const int idx = lane + 64 * i, v = idx >> 7, kk = idx & 127; const float cv = v < 4 ? c[v * 1024 + k0 + kk] : c_ctx[k0 + kk]; scr[idx] = cv / (1.0f + expf(-cv)); }
    LDS_WAIT(); asm volatile("" ::: "memory");
    float acc[5] = {0.f, 0.f, 0.f, 0.f, 0.f};
#pragma unroll 8
    for (int kk = 0; kk < 128; ++kk) { const float w = w_ada[(size_t)(k0 + kk) * NMODV_ + n];
#pragma unroll
        for (int v = 0; v < 5; ++v) acc[v] += scr[v * 128 + kk] * w; }
    const float bb = kc == 0 ? b_ada[n] : 0.f;
#pragma unroll
    for (int v = 0; v < 5; ++v) atomicAdd(mod + v * NMODV_ + n, acc[v] + bb);
    LDS_WAIT(); asm volatile("" ::: "memory");
}
__device__ __forceinline__ void norm_mod_phase(const float* X0, const float* X1, const float* g, const float* mod, int shift_idx, bfu* H, int gw, int NGW, int lane) {
    for (int m = gw; m < M_TOK; m += NGW) {
        const int mv = m < 8192 ? 4 : ((m - 8192) >> 12);
        const float* xrow = m < 8192 ? X0 + (size_t)m * D_M : X1 + (size_t)(m - 8192) * D_M;
        const f32x4* xr = (const f32x4*)xrow + lane;
        const f32x4* sh = (const f32x4*)(mod + mv * NMODV_ + shift_idx * D_M) + lane; const f32x4* sc = sh + 256; const f32x4* gg = (const f32x4*)g + lane;
        f32x4 v[4]; float s = 0.f;
#pragma unroll
        for (int j = 0; j < 4; ++j) { v[j] = xr[64 * j]; s += (v[j].x * v[j].x + v[j].y * v[j].y) + (v[j].z * v[j].z + v[j].w * v[j].w); }
        const float rstd = 1.0f / sqrtf(wave_sum(s) * (1.0f / D_M) + 1e-6f);
        v2u* o8 = (v2u*)(H + (size_t)m * D_M) + lane;
#pragma unroll
        for (int j = 0; j < 4; ++j) { const f32x4 h = v[j] * rstd * gg[64 * j] * (sc[64 * j] + 1.0f) + sh[64 * j]; v2u w; w.x = pk2(h.x, h.y); w.y = pk2(h.z, h.w); o8[64 * j] = w; }
    }
}
__device__ __forceinline__ void final_norm_phase(float* X, const float* g, int gw, int NGW, int lane) {
    for (int m = gw; m < M_TOK; m += NGW) {
        f32x4* xr = (f32x4*)(X + (size_t)m * D_M) + lane; const f32x4* gg = (const f32x4*)g + lane;
        f32x4 v[4]; float s = 0.f;
#pragma unroll
        for (int j = 0; j < 4; ++j) { v[j] = xr[64 * j]; s += (v[j].x * v[j].x + v[j].y * v[j].y) + (v[j].z * v[j].z + v[j].w * v[j].w); }
        const float rstd = 1.0f / sqrtf(wave_sum(s) * (1.0f / D_M) + 1e-6f);
#pragma unroll
        for (int j = 0; j < 4; ++j) xr[64 * j] = v[j] * rstd * gg[64 * j];
    }
}
__device__ __forceinline__ void rope_entry(float* rope, int idx) {
    const int pos = idx >> 4, j = idx & 15;
    double inv = 1.0; for (int i = 0; i < j; ++i) inv *= 0.56234132519034908;
    const float angf = (float)pos * (float)inv;
    const double ang = (double)angf;
    const double kq = rint(ang * 0.63661977236758134);
    double r = fma(-kq, 1.5707963267341256, ang); r = fma(-kq, 6.0771005065061922e-11, r);
    const double r2 = r * r;
    const double sn = r * (1.0 + r2 * (-1.0 / 6 + r2 * (1.0 / 120 + r2 * (-1.0 / 5040 + r2 * (1.0 / 362880 + r2 * (-1.0 / 39916800 + r2 * (1.0 / 6227020800.0)))))));
    const double cs = 1.0 + r2 * (-0.5 + r2 * (1.0 / 24 + r2 * (-1.0 / 720 + r2 * (1.0 / 40320 + r2 * (-1.0 / 3628800 + r2 * (1.0 / 479001600 + r2 * (-1.0 / 87178291200.0)))))));
    const int q = ((int)kq) & 3;
    const double s_ = q == 0 ? sn : q == 1 ? cs : q == 2 ? -sn : -cs;
    const double c_ = q == 0 ? cs : q == 1 ? -sn : q == 2 ? -cs : sn;
    rope[idx] = (float)c_; rope[1024 + idx] = (float)s_;
}
__device__ __forceinline__ void cache_item(const float* cdk, const float* cdv, const float* cgk, const float* cgv, bfu* KB, bfu* VB, int item, int lane) {
    const int row = item >> 1, which = item & 1;
    const int lb = row >> 9, p = row & 511; const size_t drow = (size_t)(8192 + lb * 4608 + p) * 640;
    const float* sd = (which ? cdv : cdk) + (size_t)row * 512; const float* sg = (which ? cgv : cgk) + (size_t)row * 128; bfu* dst = (which ? VB : KB) + drow;
    { const f32x4 a = *(const f32x4*)(sd + lane * 8), b = *(const f32x4*)(sd + lane * 8 + 4); v4u w; w.x = pk2(a.x, a.y); w.y = pk2(a.z, a.w); w.z = pk2(b.x, b.y); w.w = pk2(b.z, b.w); *(v4u*)(dst + lane * 8) = w; }
    if (lane < 16) { const f32x4 a = *(const f32x4*)(sg + lane * 8), b = *(const f32x4*)(sg + lane * 8 + 4); v4u w; w.x = pk2(a.x, a.y); w.y = pk2(a.z, a.w); w.z = pk2(b.x, b.y); w.w = pk2(b.z, b.w); *(v4u*)(dst + 512 + lane * 8) = w; }
}

struct Args { const float* in[27]; float* out; unsigned char* ws; };
__global__ void __launch_bounds__(NWAVES * 64, 2) fwd_megakernel(Args a) {
    extern __shared__ __attribute__((aligned(16))) unsigned char lds[];
    cg::grid_group grid = cg::this_grid();
    const int tid = threadIdx.x, lane = tid & 63, wave = __builtin_amdgcn_readfirstlane(tid >> 6);
    const int G = gridDim.x, bx = blockIdx.x; const int vcu = (G % 8 == 0) ? (bx % 8) * (G / 8) + bx / 8 : bx;
    const int gw = bx * NWAVES + wave, NGW = G * NWAVES;
    unsigned char* ws = a.ws;
    float* mod = (float*)(ws + WS_MOD); float* rope = (float*)(ws + WS_ROPE);
    bfu *WGU1 = (bfu*)(ws + WS_WGU1), *WD1 = (bfu*)(ws + WS_WD1), *WIN = (bfu*)(ws + WS_WIN), *WOUT = (bfu*)(ws + WS_WOUT), *WGU2 = (bfu*)(ws + WS_WGU2), *WD2 = (bfu*)(ws + WS_WD2);
    bfu *H = (bfu*)(ws + WS_H), *ACT = (bfu*)(ws + WS_ACT), *QB = (bfu*)(ws + WS_QB), *KB = (bfu*)(ws + WS_KB), *VB = (bfu*)(ws + WS_VB), *OB = (bfu*)(ws + WS_H);
    float* out = a.out;
    PG8_LAS unsigned char* l3 = (PG8_LAS unsigned char*)lds;

    {
        LAS float* scr = (LAS float*)(l3 + wave * 16384);
        constexpr int I_GU = 16 * 176, I_DN = 44 * 32, I_IN = 16 * 72, I_OUT = 16 * 32, I_ADA = 1152, I_CACHE = 4096;
        constexpr int NITEMS = 2 * I_GU + 2 * I_DN + I_IN + I_OUT + I_ADA + I_CACHE;
        for (int it = gw; it < NITEMS; it += NGW) {
            int r = it;
            if (r < I_ADA) { ada_item(a.in[2], a.in[7], a.in[8], a.in[9], mod, scr, r, lane); continue; } r -= I_ADA;
            if (r < I_GU) { transpose_item(a.in[11], D_M, 2 * D_FF, WGU1, 1, scr, r, lane); continue; } r -= I_GU;
            if (r < I_DN) { transpose_item(a.in[12], D_FF, D_M, WD1, 0, scr, r, lane); continue; } r -= I_DN;
            if (r < I_IN) { transpose_item(a.in[14], D_M, D_IN, WIN, 2, scr, r, lane); continue; } r -= I_IN;
            if (r < I_OUT) { transpose_item(a.in[22], D_M, D_M, WOUT, 0, scr, r, lane); continue; } r -= I_OUT;
            if (r < I_GU) { transpose_item(a.in[24], D_M, 2 * D_FF, WGU2, 1, scr, r, lane); continue; } r -= I_GU;
            if (r < I_DN) { transpose_item(a.in[25], D_FF, D_M, WD2, 0, scr, r, lane); continue; } r -= I_DN;
            cache_item(a.in[3], a.in[4], a.in[5], a.in[6], KB, VB, r, lane);
        }
        const int gt = bx * 512 + tid; if (gt < 1024) rope_entry(rope, gt);
    }
    grid.sync();
    norm_mod_phase(a.in[0], a.in[1], a.in[10], mod, 0, H, gw, NGW, lane);
    grid.sync();
#ifndef NO_P2
    { pg8::Gemm g{H, WGU1, M_TOK, 2 * D_FF, D_M}; pg8::StaticOrder S; S.init(M_TOK, 2 * D_FF, G, bx); pg8::EpiSwiglu E{ACT};
      pg8::gemm_phase<pg8::EpiSwiglu, pg8::StaticOrder, true, true>(l3, g, S, E); }
#endif
    grid.sync();
#ifndef NO_P3
    { pg8::Gemm g{ACT, WD1, M_TOK, D_M, D_FF}; pg8::StaticOrder S; S.init(M_TOK, D_M, G, bx); pg8::EpiResid E{a.in[0], a.in[1] - (size_t)8192 * D_M, out, mod, 2, 0.5f};
      pg8::gemm_phase<pg8::EpiResid, pg8::StaticOrder, true, true>(l3, g, S, E); }
#endif
    grid.sync();
    norm_mod_phase(out, out + (size_t)8192 * D_M, a.in[13], mod, 3, H, gw, NGW, lane);
    grid.sync();
#ifndef NO_P5
    { pg8::Gemm g{H, WIN, M_TOK, D_IN, D_M}; pg8::StaticOrder S; S.init(M_TOK, D_IN, G, bx); pg8::EpiQKV E{QB, KB, VB, out, a.in[15], a.in[16], rope};
      pg8::gemm_phase<pg8::EpiQKV, pg8::StaticOrder, true, true>(l3, g, S, E); }
#endif
    grid.sync();
    {
        const float p1 = wave_sum(a.in[17][lane] * a.in[18][lane]), p2 = wave_sum(a.in[19][lane] * a.in[20][lane]);
        const float lam = expf(p1) - expf(p2) + 0.2f;
        attn_body::AttnArgs A{(const attn_body::bf16*)QB, (const attn_body::bf16*)KB, (const attn_body::bf16*)VB, (attn_body::bf16*)OB, a.in[21], lam};
#ifndef NO_ATTN
        attn_body::attn_phase<8>((char*)lds, A, vcu, G);
#endif
    }
    grid.sync();
#ifndef NO_P7
    { pg8::Gemm g{OB, WOUT, M_TOK, D_M, D_M}; pg8::StaticOrder S; S.init(M_TOK, D_M, G, bx); pg8::EpiResid E{out, out, out, mod, 5, 1.0f};
      pg8::gemm_phase<pg8::EpiResid, pg8::StaticOrder, true, true>(l3, g, S, E); }
#endif
    grid.sync();
    norm_mod_phase(out, out + (size_t)8192 * D_M, a.in[23], mod, 6, H, gw, NGW, lane);
    grid.sync();
#ifndef NO_P9
    { pg8::Gemm g{H, WGU2, M_TOK, 2 * D_FF, D_M}; pg8::StaticOrder S; S.init(M_TOK, 2 * D_FF, G, bx); pg8::EpiSwiglu E{ACT};
      pg8::gemm_phase<pg8::EpiSwiglu, pg8::StaticOrder, true, true>(l3, g, S, E); }
#endif
    grid.sync();
#ifndef NO_P10
    { pg8::Gemm g{ACT, WD2, M_TOK, D_M, D_FF}; pg8::StaticOrder S; S.init(M_TOK, D_M, G, bx); pg8::EpiResid E{out, out, out, mod, 8, 0.5f};
      pg8::gemm_phase<pg8::EpiResid, pg8::StaticOrder, true, true>(l3, g, S, E); }
#endif
    grid.sync();
    final_norm_phase(out, a.in[26], gw, NGW, lane);
}

extern "C" void kernel_launch(void* const* d_in, const int* in_sizes, int n_in, void* d_out, int out_size, void* d_ws, size_t ws_size, hipStream_t stream) {
    static int grid = 0;
    if (grid == 0) {
        if (n_in != 27 || ws_size < WS_END) { fprintf(stderr, "kernel_launch: unexpected n_in %d / ws %zu\n", n_in, ws_size); grid = -1; return; }
        int dev = 0, cus = 0, per_cu = 0;
        (void)hipGetDevice(&dev);
        (void)hipDeviceGetAttribute(&cus, hipDeviceAttributeMultiprocessorCount, dev);
        (void)hipFuncSetAttribute((const void*)fwd_megakernel, hipFuncAttributeMaxDynamicSharedMemorySize, LDS_BYTES);
        (void)hipOccupancyMaxActiveBlocksPerMultiprocessor(&per_cu, (const void*)fwd_megakernel, NWAVES * 64, LDS_BYTES);
        if (per_cu < 1) { fprintf(stderr, "kernel_launch: occupancy query says %d blocks/CU\n", per_cu); per_cu = 1; }
        grid = cus * per_cu;
    }
    if (grid < 0) return;
    (void)hipMemsetAsync((char*)d_ws + WS_MOD, 0, 5 * 9216 * 4, stream);
    Args a{};
    for (int i = 0; i < 27; ++i) a.in[i] = (const float*)d_in[i];
    a.out = (float*)d_out; a.ws = (unsigned char*)d_ws;
    void* args[] = {&a};
    hipError_t e = hipLaunchCooperativeKernel((const void*)fwd_megakernel, dim3(grid), dim3(NWAVES * 64), args, LDS_BYTES, stream);
    if (e != hipSuccess) fprintf(stderr, "cooperative launch failed: %s (grid %d)\n", hipGetErrorString(e), grid);
}
```

```cpp
#include <hip/hip_runtime.h>
#include <hip/hip_cooperative_groups.h>
#include <hip/hip_bf16.h>
#include <cstdio>
#include <cstdint>
#include <cmath>
namespace cg = cooperative_groups;
namespace pg8 {
#define PG8_LAS __attribute__((address_space(3)))
typedef unsigned short bf16_t;
typedef short bf16x8 __attribute__((ext_vector_type(8)));
typedef float f32x4 __attribute__((ext_vector_type(4)));
typedef unsigned u32x4 __attribute__((ext_vector_type(4)));
constexpr int BM = 256, BK = 64, HALF = 128, HTB = HALF * BK * 2  , STAGE_BYTES = 8 * HTB, NXCD = 8, WGM = 8;

__host__ __device__ __forceinline__ int lds_byte(int r, int c) { const int st = (r >> 4) * 2 + (c >> 5), rr = r & 15, cc = c & 31, ob = rr * 64 + cc * 2; return st * 1024 + (ob ^ (((ob >> 9) & 1) << 5)); }
__host__ __device__ __forceinline__ void stage_rc(int b, int& R, int& C) { const int st = b / 1024, sb = b % 1024, swz = sb ^ (((sb >> 9) & 1) << 5); R = (st >> 1) * 16 + swz / 64; C = (st & 1) * 32 + (swz % 64) / 2; }
__host__ __device__ __forceinline__ int perm32(int rho) { const int n = rho >> 4, i = rho & 15; return 8 * (i >> 2) + 4 * n + (i & 3); }

struct Unit { int pm, pn, half; };
struct Gemm { const bf16_t* A; const bf16_t* Bt; int M, N, K; };

struct StaticOrder {
    int nM, nN, nwg, G, c, nfull, ntot;
    __host__ __device__ void init(int M, int N, int G_, int c_, bool split = true) { nM = M / BM; nN = N / BM; nwg = nM * nN; G = G_; c = c_;
        const int R = nwg % G; const bool sp = split && R > 0 && 2 * R <= G; nfull = sp ? nwg - R : nwg; ntot = nfull + 2 * (nwg - nfull); }
    __host__ __device__ bool next(int i, Unit& u) const {
        const long L = (long)i * G + c; if (L >= ntot) return false;
        int wgid; if (L < nfull) { wgid = (int)L; u.half = -1; } else { wgid = nfull + (int)(L - nfull) / 2; u.half = (int)(L - nfull) & 1; }
        { const int q = nwg / NXCD, r = nwg % NXCD, xcd = wgid % NXCD, off = wgid / NXCD; wgid = (xcd < r ? xcd * (q + 1) : r * (q + 1) + (xcd - r) * q) + off; }
        const int nig = WGM * nN, gid = wgid / nig, fm = gid * WGM, gsz = (nM - fm) < WGM ? (nM - fm) : WGM;
        u.pm = fm + ((wgid % nig) % gsz); u.pn = (wgid % nig) / gsz; return true;
    }
    __device__ __forceinline__ void a_ready(const Unit&) const {}
    __device__ __forceinline__ void done(const Unit&) const {}
};

__device__ __forceinline__ unsigned cvt_pk_bf16(float lo, float hi) { unsigned r; asm volatile("v_cvt_pk_bf16_f32 %0, %1, %2" : "=v"(r) : "v"(lo), "v"(hi)); return r; }
typedef float f32x2 __attribute__((ext_vector_type(2)));
typedef unsigned u32x2 __attribute__((ext_vector_type(2)));
constexpr float ATT_C2 = 0.125f * 1.4426950408889634f;
constexpr int NTOK = 24576, NCTX = 8192, DMODEL = 1024, DFF = 2816, NMODV = 9216;
constexpr int OFF_DK = 25165824, OFF_DV = 29360128, OFF_GK = 33554432, OFF_GV = 34603008;
__device__ __forceinline__ float silu_f(float g) { return g * __builtin_amdgcn_rcpf(1.0f + __builtin_amdgcn_exp2f(-1.4426950408889634f * g)); }
struct EpiSwiglu {
    static constexpr bool PERM = true, AFTER_DRAIN = false;
    bf16_t* O;
    __device__ __forceinline__ void operator()(const f32x4 (&acc)[2][2][4][2], const Unit& u, int wr, int wc, int fr_, int fq_) const {
        int fr = fr_, fq = fq_; asm volatile("" : "+v"(fr), "+v"(fq));
        const int row0 = u.pm * BM + (u.half > 0 ? HALF : 0) + wr * 64 + fr, col0 = u.pn * 128 + wc * 32 + 8 * fq;
#pragma unroll
        for (int ai = 0; ai < 2; ++ai)
#pragma unroll
            for (int m = 0; m < 4; ++m) {
                if (ai == 1 && u.half >= 0) continue;
                bf16_t* rowp = O + (size_t)(row0 + ai * HALF + m * 16) * DFF + col0;
                const f32x4 g0 = acc[ai][0][m][0], g1 = acc[ai][0][m][1], u0 = acc[ai][1][m][0], u1 = acc[ai][1][m][1];
                u32x4 w;
                w.x = cvt_pk_bf16(silu_f(g0[0]) * u0[0], silu_f(g0[1]) * u0[1]); w.y = cvt_pk_bf16(silu_f(g0[2]) * u0[2], silu_f(g0[3]) * u0[3]);
                w.z = cvt_pk_bf16(silu_f(g1[0]) * u1[0], silu_f(g1[1]) * u1[1]); w.w = cvt_pk_bf16(silu_f(g1[2]) * u1[2], silu_f(g1[3]) * u1[3]);
                *(u32x4*)rowp = w;
            }
    }
};
template <bool NTL> struct EpiResidT {
    static constexpr bool PERM = false, AFTER_DRAIN = false;
    const float* base; const float* base2; float* out; const float* mod; int gate_idx; float coef;
    __device__ __forceinline__ void operator()(const f32x4 (&acc)[2][2][4][2], const Unit& u, int wr, int wc, int fr_, int fq_) const {
        int fr = fr_, fq = fq_; asm volatile("" : "+v"(fr), "+v"(fq));
        const int mv = (u.pm < 32) ? 4 : ((u.pm - 32) >> 4);
        const float* gate = mod + mv * NMODV + gate_idx * DMODEL; const float* bs = (u.pm < 32) ? base : base2;
        const int row0 = u.pm * BM + (u.half > 0 ? HALF : 0) + wr * 64 + fr, col0 = u.pn * BM + wc * 32 + 4 * fq;
        f32x4 gv[2][2];
#pragma unroll
        for (int bj = 0; bj < 2; ++bj)
#pragma unroll
            for (int n = 0; n < 2; ++n) gv[bj][n] = *(const f32x4*)(gate + col0 + bj * HALF + n * 16) * coef;
#pragma unroll
        for (int ai = 0; ai < 2; ++ai)
#pragma unroll
            for (int m = 0; m < 4; ++m) {
                if (ai == 1 && u.half >= 0) continue;
                const size_t off = (size_t)(row0 + ai * HALF + m * 16) * DMODEL + col0;
#pragma unroll
                for (int bj = 0; bj < 2; ++bj)
#pragma unroll
                    for (int n = 0; n < 2; ++n) { const f32x4* bp = (const f32x4*)(bs + off + bj * HALF + n * 16); const f32x4 b = NTL ? __builtin_nontemporal_load(bp) : *bp; *(f32x4*)(out + off + bj * HALF + n * 16) = b + gv[bj][n] * acc[ai][bj][m][n]; }
                if (m & 1) asm volatile("" ::: "memory");
            }
    }
};
struct EpiQKV {
    static constexpr bool PERM = false, AFTER_DRAIN = false;
    bf16_t *QB, *KB, *VB; float* out; const float* qn; const float* kn; const float* rope;
    __device__ __forceinline__ void operator()(const f32x4 (&acc)[2][2][4][2], const Unit& u, int wr, int wc, int fr_, int fq_) const {
        int fr = fr_, fq = fq_; asm volatile("" : "+v"(fr), "+v"(fq));
        const int ch = u.pn * 4 + wc; const bool ctx = u.pm < 32;
        int kind, cc;
        if (ch < 8) { kind = 0; cc = ch; } else if (ch < 16) { kind = 1; cc = ch - 8; } else if (ch < 24) { kind = 2; cc = ch - 16; } else if (ch < 32) { kind = 3; cc = ch - 24; } else if (ch < 34) { kind = 4; cc = ch - 32; } else { kind = 5; cc = ch - 34; }
        const bool do_norm = (kind == 3 || kind == 4), do_rope = !ctx && (kind == 0 || kind == 1 || kind == 3 || kind == 4);
        const float qscale = (kind == 0 || kind == 3) ? ATT_C2 : 1.0f;
        bf16_t* dst; int dpitch, dcol; float* fo = nullptr; int fpitch = 0, fcol = 0;
        if (kind == 0) { dst = QB; dpitch = 1024; dcol = 64 * cc; }
        else if (kind == 3) { dst = QB; dpitch = 1024; dcol = 512 + 64 * cc; }
        else if (kind == 1) { dst = KB; dpitch = 640; dcol = 64 * cc; fo = out + OFF_DK; fpitch = 512; fcol = 64 * cc; }
        else if (kind == 4) { dst = KB; dpitch = 640; dcol = 512 + 64 * cc; fo = out + OFF_GK; fpitch = 128; fcol = 64 * cc; }
        else if (kind == 2) { dst = VB; dpitch = 640; dcol = 64 * cc; fo = out + OFF_DV; fpitch = 512; fcol = 64 * cc; }
        else { dst = VB; dpitch = 640; dcol = 512 + 64 * cc; fo = out + OFF_GV; fpitch = 128; fcol = 64 * cc; }
        const bool isq = (kind == 0 || kind == 3);
        const float* gnorm = (kind == 3 ? qn : kn) + 4 * fq;
#pragma unroll
        for (int ai = 0; ai < 2; ++ai)
#pragma unroll
            for (int m = 0; m < 4; ++m) {
                if (ai == 1 && u.half >= 0) continue;
                const int row = u.pm * BM + (u.half > 0 ? HALF : 0) + ai * HALF + wr * 64 + m * 16 + fr;
                f32x4 v[2][2];
#pragma unroll
                for (int bj = 0; bj < 2; ++bj)
#pragma unroll
                    for (int n = 0; n < 2; ++n) v[bj][n] = acc[ai][bj][m][n];
                if (do_norm) {
                    float ss = 0.f;
#pragma unroll
                    for (int bj = 0; bj < 2; ++bj)
#pragma unroll
                        for (int n = 0; n < 2; ++n) { const f32x4 x = v[bj][n]; ss += (x[0] * x[0] + x[1] * x[1]) + (x[2] * x[2] + x[3] * x[3]); }
                    ss += __shfl_xor(ss, 16); ss += __shfl_xor(ss, 32);
                    const float r = 1.0f / sqrtf(ss * (1.0f / 64.0f) + 1e-6f);
#pragma unroll
                    for (int bj = 0; bj < 2; ++bj)
#pragma unroll
                        for (int n = 0; n < 2; ++n) v[bj][n] = v[bj][n] * r * *(const f32x4*)(gnorm + 32 * bj + 16 * n);
                }
                int drow = row;
                if (ctx) {
                    if (fo) {
#pragma unroll
                        for (int bj = 0; bj < 2; ++bj)
#pragma unroll
                            for (int n = 0; n < 2; ++n) __builtin_nontemporal_store(v[bj][n], (f32x4*)(fo + (size_t)row * fpitch + fcol + 32 * bj + 16 * n + 4 * fq));
                    }
                } else {
                    const int tl = (row - NCTX) & 4095, lb = (row - NCTX) >> 12;
                    if (!isq) drow = NCTX + lb * 4608 + 512 + tl;
                    if (do_rope) {
#pragma unroll
                        for (int bj = 0; bj < 2; ++bj) {
                            const int pos = bj == 0 ? (tl >> 6) : (tl & 63);
                            const f32x4 c4 = *(const f32x4*)(rope + pos * 16 + 4 * fq), s4 = *(const f32x4*)(rope + 1024 + pos * 16 + 4 * fq);
                            const f32x4 x1 = v[bj][0], x2 = v[bj][1];
                            v[bj][0] = x1 * c4 - x2 * s4; v[bj][1] = x1 * s4 + x2 * c4;
                        }
                    }
                }
                bf16_t* dp = dst + (size_t)drow * dpitch + dcol + ((fq & 1) ? 16 + 4 * (fq - 1) : 4 * fq);
#pragma unroll
                for (int bj = 0; bj < 2; ++bj) { const f32x4 xa = v[bj][0] * qscale, xb = v[bj][1] * qscale;
                    unsigned a0 = cvt_pk_bf16(xa[0], xa[1]), a1 = cvt_pk_bf16(xa[2], xa[3]), b0 = cvt_pk_bf16(xb[0], xb[1]), b1 = cvt_pk_bf16(xb[2], xb[3]);
                    { auto r = __builtin_amdgcn_permlane16_swap(a0, b0, false, false); a0 = r[0]; b0 = r[1]; }
                    { auto r = __builtin_amdgcn_permlane16_swap(a1, b1, false, false); a1 = r[0]; b1 = r[1]; }
                    u32x4 w; w.x = a0; w.y = a1; w.z = b0; w.w = b1; *(u32x4*)(dp + 32 * bj) = w; }
                if (m & 1) { asm volatile("" ::: "memory"); __builtin_amdgcn_sched_barrier(0); }
            }
    }
};
template <class Epi, class Sched, bool ALIGN_EPI = false, bool SP2 = false>
__device__ __forceinline__ void gemm_phase(PG8_LAS unsigned char* lds, const Gemm g, const Sched& S, const Epi& E) {
    int tid_ = threadIdx.x; asm volatile("" : "+v"(tid_));
    const int tid = tid_, wid = __builtin_amdgcn_readfirstlane(tid >> 6), lane = tid & 63, wr = wid >> 2, wc = wid & 3, fr = lane & 15, fq = lane >> 4;
    const int K = g.K, nt = K / BK;
    unsigned voffA[2], voffB[2];
#pragma unroll
    for (int i = 0; i < 2; ++i) { int R, C; stage_rc(tid * 16 + i * 8192, R, C); const int Rb = Epi::PERM ? ((R & ~31) + perm32(R & 31)) : R;
        voffA[i] = (unsigned)(R * K + C) * 2u; voffB[i] = (unsigned)(Rb * K + C) * 2u; }
    const size_t kstep = (size_t)(BK * 2);
    const size_t hstep = (size_t)HALF * K * 2;
    const size_t tstep = 2 * hstep;
    const unsigned ldsw = (unsigned)wid * 1024u;
    const int aoff = lds_byte(wr * 64 + fr, fq * 8), boff = lds_byte(wc * 32 + fr, fq * 8);
#define PG8_SA(b, h) (((b) * 2 + (h)) * HTB)
#define PG8_SB(b, h) ((4 + (b) * 2 + (h)) * HTB)
#define PG8_STAGE(bufoff, gbase, voff) do { _Pragma("unroll") for (int _i = 0; _i < 2; ++_i) \
        __builtin_amdgcn_global_load_lds((const unsigned*)((const char*)(gbase) + (voff)[_i]), (PG8_LAS unsigned*)(lds + (bufoff) + ldsw + _i * 8192), 16, 0, 0); } while (0)
#define PG8_LDA(dst, b, h) do { _Pragma("unroll") for (int m = 0; m < 4; ++m) _Pragma("unroll") for (int k = 0; k < 2; ++k) dst[m][k] = *(const PG8_LAS bf16x8*)(lds + PG8_SA(b, h) + aoff + m * 2048 + k * 1024); } while (0)
#define PG8_LDB(dst, b, h) do { _Pragma("unroll") for (int n = 0; n < 2; ++n) _Pragma("unroll") for (int k = 0; k < 2; ++k) dst[n][k] = *(const PG8_LAS bf16x8*)(lds + PG8_SB(b, h) + boff + n * 2048 + k * 1024); } while (0)
#define PG8_MMA(ai, bj, At, Bt) do { __builtin_amdgcn_s_setprio(1); _Pragma("unroll") for (int m = 0; m < 4; ++m) _Pragma("unroll") for (int n = 0; n < 2; ++n) _Pragma("unroll") for (int k = 0; k < 2; ++k) \
        acc[ai][bj][m][n] = __builtin_amdgcn_mfma_f32_16x16x32_bf16(Bt[n][k], At[m][k], acc[ai][bj][m][n], 0, 0, 0); __builtin_amdgcn_s_setprio(0); } while (0)
#define PG8_WAIT_V(n) asm volatile("s_waitcnt vmcnt(" #n ")" ::: "memory")
#define PG8_WAIT_L(n) asm volatile("s_waitcnt lgkmcnt(" #n ")" ::: "memory")
#define PG8_BAR __builtin_amdgcn_s_barrier()
#define PG8_SCHED __builtin_amdgcn_sched_barrier(0)
    Unit cur, nxt; int ui = 0;
    if (!S.next(0, cur)) return;
    f32x4 acc[2][2][4][2];
#pragma unroll
    for (int a = 0; a < 2; ++a)
#pragma unroll
        for (int b = 0; b < 2; ++b)
#pragma unroll
            for (int m = 0; m < 4; ++m)
#pragma unroll
                for (int n = 0; n < 2; ++n) acc[a][b][m][n] = (f32x4){0.f, 0.f, 0.f, 0.f};
    bf16x8 At[4][2], B0[2][2], B1[2][2];
    const char* cA = (const char*)g.A + (size_t)cur.pm * tstep + (cur.half > 0 ? hstep : 0); const char* cB = (const char*)g.Bt + (size_t)cur.pn * tstep;
    size_t hcur = cur.half < 0 ? hstep : 0, hnxt = 0;
    S.a_ready(cur);
    if constexpr (SP2) {
        PG8_STAGE(PG8_SB(0, 0), cB, voffB); PG8_STAGE(PG8_SB(0, 1), cB + hstep, voffB); PG8_STAGE(PG8_SA(0, 0), cA, voffA); PG8_STAGE(PG8_SA(0, 1), cA + hcur, voffA);
        if (wr == 1) PG8_BAR;
        PG8_WAIT_V(2); PG8_BAR;
        PG8_STAGE(PG8_SB(1, 0), cB + kstep, voffB); PG8_STAGE(PG8_SA(1, 0), cA + kstep, voffA); PG8_STAGE(PG8_SB(1, 1), cB + hstep + kstep, voffB);
        PG8_WAIT_V(6); PG8_BAR;
    } else {
        PG8_STAGE(PG8_SB(0, 0), cB, voffB); PG8_STAGE(PG8_SA(0, 0), cA, voffA); PG8_STAGE(PG8_SB(0, 1), cB + hstep, voffB); PG8_STAGE(PG8_SA(0, 1), cA + hstep, voffA);
        if (wr == 1) PG8_BAR;
        PG8_WAIT_V(4); PG8_BAR;
        PG8_STAGE(PG8_SB(1, 0), cB + kstep, voffB); PG8_STAGE(PG8_SA(1, 0), cA + kstep, voffA); PG8_STAGE(PG8_SB(1, 1), cB + hstep + kstep, voffB);
        PG8_WAIT_V(6); PG8_BAR;
    }
    for (;;) {
        const bool has_next = S.next(ui + 1, nxt);
        const char* nA = has_next ? (const char*)g.A + (size_t)nxt.pm * tstep + (nxt.half > 0 ? hstep : 0) : cA; const char* nB = has_next ? (const char*)g.Bt + (size_t)nxt.pn * tstep : cB;
        hnxt = has_next ? (nxt.half < 0 ? hstep : 0) : hcur; const bool fullu = cur.half < 0;
        for (int t = 0; t < nt; t += 2) {
            const bool last = (t == nt - 2);
            const char* a1 = cA + (size_t)(t + 1) * kstep;
            const char* a2 = last ? nA : cA + (size_t)(t + 2) * kstep; const char* b2 = last ? nB : cB + (size_t)(t + 2) * kstep;
            const char* a3 = a2 + kstep; const char* b3 = b2 + kstep;
            if (last && has_next) S.a_ready(nxt);
            if constexpr (SP2) {
            PG8_LDB(B0, 0, 0); PG8_LDB(B1, 0, 1); PG8_SCHED; PG8_LDA(At, 0, 0); PG8_STAGE(PG8_SA(1, 1), a1 + hcur, voffA);
            PG8_WAIT_V(8); PG8_WAIT_L(0); PG8_BAR; PG8_MMA(0, 0, At, B0); PG8_MMA(0, 1, At, B1); PG8_BAR; PG8_SCHED;
            if (fullu) PG8_LDA(At, 0, 1); PG8_STAGE(PG8_SB(0, 0), b2, voffB); PG8_STAGE(PG8_SB(0, 1), b2 + hstep, voffB); PG8_STAGE(PG8_SA(0, 0), a2, voffA);
            PG8_WAIT_V(8); PG8_WAIT_L(0); PG8_BAR; if (fullu) { PG8_MMA(1, 0, At, B0); PG8_MMA(1, 1, At, B1); } PG8_BAR; PG8_SCHED;
            PG8_LDB(B0, 1, 0); PG8_LDB(B1, 1, 1); PG8_SCHED; PG8_LDA(At, 1, 0); PG8_STAGE(PG8_SA(0, 1), a2 + (last ? hnxt : hcur), voffA);
            PG8_WAIT_V(8); PG8_WAIT_L(0); PG8_BAR; PG8_MMA(0, 0, At, B0); PG8_MMA(0, 1, At, B1); PG8_BAR; PG8_SCHED;
            if (fullu) PG8_LDA(At, 1, 1); PG8_STAGE(PG8_SB(1, 0), b3, voffB); PG8_STAGE(PG8_SB(1, 1), b3 + hstep, voffB); PG8_STAGE(PG8_SA(1, 0), a3, voffA);
            PG8_WAIT_V(8); PG8_WAIT_L(0); PG8_BAR; if (fullu) { PG8_MMA(1, 0, At, B0); PG8_MMA(1, 1, At, B1); } PG8_BAR; PG8_SCHED;
            } else {
            PG8_LDB(B0, 0, 0); PG8_SCHED; PG8_LDA(At, 0, 0); PG8_STAGE(PG8_SA(1, 1), a1 + hstep, voffA);
            PG8_WAIT_L(8); PG8_BAR; PG8_WAIT_L(0); PG8_MMA(0, 0, At, B0); PG8_BAR; PG8_SCHED;
            PG8_LDB(B1, 0, 1); PG8_STAGE(PG8_SB(0, 0), b2, voffB);
            PG8_BAR; PG8_WAIT_L(0); PG8_MMA(0, 1, At, B1); PG8_BAR;
            PG8_LDA(At, 0, 1); PG8_STAGE(PG8_SA(0, 0), a2, voffA);
            PG8_BAR; PG8_WAIT_L(0); PG8_MMA(1, 0, At, B0); PG8_BAR; PG8_SCHED;
            PG8_STAGE(PG8_SB(0, 1), b2 + hstep, voffB);
            PG8_WAIT_V(6); PG8_BAR; PG8_MMA(1, 1, At, B1); PG8_BAR;
            PG8_LDB(B0, 1, 0); PG8_SCHED; PG8_LDA(At, 1, 0); PG8_STAGE(PG8_SA(0, 1), a2 + hstep, voffA);
            PG8_WAIT_L(8); PG8_BAR; PG8_WAIT_L(0); PG8_MMA(0, 0, At, B0); PG8_BAR; PG8_SCHED;
            PG8_LDB(B1, 1, 1); PG8_STAGE(PG8_SB(1, 0), b3, voffB);
            PG8_BAR; PG8_WAIT_L(0); PG8_MMA(0, 1, At, B1); PG8_BAR;
            PG8_LDA(At, 1, 1); PG8_STAGE(PG8_SA(1, 0), a3, voffA);
            PG8_BAR; PG8_WAIT_L(0); PG8_MMA(1, 0, At, B0); PG8_BAR; PG8_SCHED;
            PG8_STAGE(PG8_SB(1, 1), b3 + hstep, voffB);
            PG8_WAIT_V(6); PG8_BAR; PG8_MMA(1, 1, At, B1); PG8_BAR;
            }
        }
        if constexpr (ALIGN_EPI) { if (wr == 0) PG8_BAR; }
        if constexpr (!Epi::AFTER_DRAIN) { E(acc, cur, wr, wc, fr, fq); S.done(cur); }
        if (!has_next) break;
#pragma unroll
        for (int a = 0; a < 2; ++a)
#pragma unroll
            for (int b = 0; b < 2; ++b)
#pragma unroll
                for (int m = 0; m < 4; ++m)
#pragma unroll
                    for (int n = 0; n < 2; ++n) acc[a][b][m][n] = (f32x4){0.f, 0.f, 0.f, 0.f};
        cur = nxt; cA = nA; cB = nB; hcur = hnxt; ++ui;
        if constexpr (ALIGN_EPI) { if (wr == 1) PG8_BAR; }
    }
    PG8_WAIT_V(0);
    if constexpr (!ALIGN_EPI) { if (wr == 0) PG8_BAR; }
    PG8_BAR;
    if constexpr (Epi::AFTER_DRAIN) { E.fused(acc, cur, wr, wc, fr, fq, lds, wid, lane); S.done(cur); }
#undef PG8_SA
#undef PG8_SB
#undef PG8_STAGE
#undef PG8_LDA
#undef PG8_LDB
#undef PG8_MMA
#undef PG8_WAIT_V
#undef PG8_WAIT_L
#undef PG8_BAR
#undef PG8_SCHED
}
}

#ifndef PG8_SP2
#define PG8_SP2 true
#endif
#ifndef PG8_ALIGN
#define PG8_ALIGN true
#endif
namespace attn_body {
using bf16=__hip_bfloat16;
using bf16x8=__attribute__((ext_vector_type(8)))short;
using s16x4=__attribute__((ext_vector_type(4)))short;
using f32x16=__attribute__((ext_vector_type(16)))float;
using u32x4=__attribute__((ext_vector_type(4)))unsigned;
constexpr int D=64;
constexpr int NW=8,QBLK=32,QB=QBLK*NW,KVBLK=64;
__device__ __forceinline__ int crow(int r,int hi){return (r&3)+8*(r>>2)+4*hi;}
#define SBAR() __builtin_amdgcn_sched_barrier(0)
__device__ __forceinline__ void cmask(f32x16&p0,f32x16&p1,int jb,int qrel,int hi){
  const float NEG=-INFINITY; int kb=64*jb+4*hi;
  #pragma unroll
  for(int r=0;r<16;++r){int kv=kb+(r&3)+8*(r>>2); if(kv>qrel)p0[r]=NEG; if(kv+32>qrel)p1[r]=NEG;}
}

constexpr int NSLOT=3, SLOTB=8192;
constexpr int LDS_K=0, LDS_V=NSLOT*SLOTB, LDS_WS=LDS_V+NSLOT*2*SLOTB, LDS_OST=LDS_WS+NW*64*4, LDS_BYTES=LDS_OST+NW*8192;
constexpr float C2=0.125f*1.4426950408889634f;
__device__ __forceinline__ void glds16(const void*gsrc,unsigned lds_dst){unsigned keep;
  asm volatile("s_mov_b32 %0, m0\n\ts_mov_b32 m0, %2\n\ts_nop 0\n\tglobal_load_lds_dwordx4 %1, off\n\ts_mov_b32 m0, %0":"=&s"(keep):"v"(gsrc),"s"(lds_dst):"memory");}
__device__ __forceinline__ float max3f(float a,float b,float c){float r;asm("v_max3_f32 %0, %1, %2, %3":"=v"(r):"v"(a),"v"(b),"v"(c));return r;}
__device__ __forceinline__ float max2f(float a,float b){float r;asm("v_max_f32_e32 %0, %1, %2":"=v"(r):"v"(a),"v"(b));return r;}
__device__ __forceinline__ float fadd_s(float a,float b){float r;asm("v_add_f32_e32 %0, %1, %2":"=v"(r):"v"(a),"v"(b));return r;}
__device__ __forceinline__ float fsub_s(float a,float b){float r;asm("v_sub_f32_e32 %0, %1, %2":"=v"(r):"v"(a),"v"(b));return r;}
typedef float f32x2_t __attribute__((ext_vector_type(2))); typedef __bf16 bf16x2_t __attribute__((ext_vector_type(2)));
__device__ __forceinline__ unsigned cvtpk_s(float lo,float hi){f32x2_t v={lo,hi};bf16x2_t b=__builtin_convertvector(v,bf16x2_t);return __builtin_bit_cast(unsigned,b);}
#define WAIT_BAR(N) asm volatile("s_waitcnt vmcnt(" #N ") lgkmcnt(0)\n\ts_barrier":::"memory")

__device__ __forceinline__ void qkt(f32x16&p0,f32x16&p1,const char*Kslot,const bf16x8*qr,const f32x16&negm,int r32,int hi){
  const char*kb=Kslot+hi*1024+r32*16;
  #pragma unroll
  for(int d0=0;d0<4;++d0){
    const bf16x8 b0=*reinterpret_cast<const bf16x8*>(kb+d0*2048);
    const bf16x8 b1=*reinterpret_cast<const bf16x8*>(kb+d0*2048+512);
    if(d0==0){p0=__builtin_amdgcn_mfma_f32_32x32x16_bf16(b0,qr[0],negm,0,0,0);p1=__builtin_amdgcn_mfma_f32_32x32x16_bf16(b1,qr[0],negm,0,0,0);}
    else{p0=__builtin_amdgcn_mfma_f32_32x32x16_bf16(b0,qr[d0],p0,0,0,0);p1=__builtin_amdgcn_mfma_f32_32x32x16_bf16(b1,qr[d0],p1,0,0,0);}}
}
typedef __attribute__((address_space(3))) const char* lds_cptr;
typedef short v4i16_t __attribute__((ext_vector_type(4)));
__device__ __forceinline__ void kload8(bf16x8*kf,lds_cptr kp){
  kf[0]=*(const __attribute__((address_space(3))) bf16x8*)(kp);      kf[1]=*(const __attribute__((address_space(3))) bf16x8*)(kp+512);
  kf[2]=*(const __attribute__((address_space(3))) bf16x8*)(kp+2048); kf[3]=*(const __attribute__((address_space(3))) bf16x8*)(kp+2560);
  kf[4]=*(const __attribute__((address_space(3))) bf16x8*)(kp+4096); kf[5]=*(const __attribute__((address_space(3))) bf16x8*)(kp+4608);
  kf[6]=*(const __attribute__((address_space(3))) bf16x8*)(kp+6144); kf[7]=*(const __attribute__((address_space(3))) bf16x8*)(kp+6656);
}
__device__ __forceinline__ void kload2(bf16x8*kf,lds_cptr kp,int j){ kf[2*j]=*(const __attribute__((address_space(3))) bf16x8*)(kp+j*2048); kf[2*j+1]=*(const __attribute__((address_space(3))) bf16x8*)(kp+j*2048+512); }
__device__ __forceinline__ s16x4 vtr(lds_cptr p){ return __builtin_bit_cast(s16x4,__builtin_amdgcn_ds_read_tr16_b64_v4i16((__attribute__((address_space(3))) v4i16_t*)p)); }
__device__ __forceinline__ float rowmax(const f32x16&p0,const f32x16&p1){
  float a=max3f(p0[0],p0[1],p1[0]),b=max3f(p0[2],p0[3],p1[1]);a=max3f(a,p1[2],p1[3]);
  #pragma unroll
  for(int r=4;r<16;r+=4){a=max3f(a,p0[r],p0[r+1]);b=max3f(b,p0[r+2],p0[r+3]);a=max3f(a,p1[r],p1[r+1]);b=max3f(b,p1[r+2],p1[r+3]);}
  const float m=max2f(a,b);
  auto rr=__builtin_amdgcn_permlane32_swap(__float_as_uint(m),__float_as_uint(m),false,false);
  return max2f(__uint_as_float(rr[0]),__uint_as_float(rr[1]));
}
template<int NVQ> __device__ __forceinline__ void pv(f32x16*o,int vb,bf16x8 pa0,bf16x8 pa1,bf16x8 pa2,bf16x8 pa3){
  #pragma unroll
  for(int d0=0;d0<NVQ;++d0){s16x4 lo[4],hi[4];
    #pragma unroll
    for(int ks=0;ks<4;++ks){
      asm volatile("ds_read_b64_tr_b16 %0,%1 offset:%c2":"=&v"(lo[ks]):"v"(vb),"i"(d0*4096+ks*1024):"memory");
      asm volatile("ds_read_b64_tr_b16 %0,%1 offset:%c2":"=&v"(hi[ks]):"v"(vb),"i"(d0*4096+ks*1024+512):"memory");}
    asm volatile("s_waitcnt lgkmcnt(0)":::"memory");SBAR();
    #define PK(k) (bf16x8){lo[k][0],lo[k][1],lo[k][2],lo[k][3],hi[k][0],hi[k][1],hi[k][2],hi[k][3]}
    o[d0]=__builtin_amdgcn_mfma_f32_32x32x16_bf16(pa0,PK(0),o[d0],0,0,0);
    o[d0]=__builtin_amdgcn_mfma_f32_32x32x16_bf16(pa1,PK(1),o[d0],0,0,0);
    o[d0]=__builtin_amdgcn_mfma_f32_32x32x16_bf16(pa2,PK(2),o[d0],0,0,0);
    o[d0]=__builtin_amdgcn_mfma_f32_32x32x16_bf16(pa3,PK(3),o[d0],0,0,0);
    #undef PK
  }
}

#ifndef ATTN_STORE16
#define ATTN_STORE16(p,v) (*(u32x4*)(p)=(v))
#endif
template<int THRL,int QP,int KP,int NVQ> __device__ __forceinline__ void attn_pass(const bf16*Qblk,const bf16*__restrict__ Kh,const bf16*__restrict__ Vh,int NT,bf16*Odst,int ecol,float lam,int MODE,char*shm){
  int tid_=threadIdx.x; asm volatile("":"+v"(tid_)); const int tid=tid_,lane=tid&63,r32=lane&31,hi=lane>>5; const int wid=__builtin_amdgcn_readfirstlane(tid>>6);
  const bf16*Qw=Qblk+(long)(wid*QBLK)*QP;
  const unsigned lds0=(unsigned)(uintptr_t)shm;
  float*wsf=(float*)(shm+LDS_WS)+wid*64;
  const bf16*ksrc=Kh+(long)lane*KP+wid*8;
  const bf16*vsrc=Vh+(long)(16*(wid&3)+(lane>>2))*KP+(wid>>2)*32+(lane&3)*8;
  const unsigned kdst=lds0+LDS_K+wid*1024, vdst=lds0+LDS_V+wid*1024;
  #define DMA_K(t,slot) glds16(ksrc+(long)(t)*KVBLK*KP,(unsigned)__builtin_amdgcn_readfirstlane(kdst+(slot)))
  #define DMA_V(t,slot) do{ glds16(vsrc+(long)(t)*KVBLK*KP,(unsigned)__builtin_amdgcn_readfirstlane(vdst+2*(slot))); if constexpr(NVQ==4) glds16(vsrc+(long)(t)*KVBLK*KP+64,(unsigned)__builtin_amdgcn_readfirstlane(vdst+2*(slot)+8192)); }while(0)
  #define WAITB(n2,n4) do{ if constexpr(NVQ==4){WAIT_BAR(n4);} else {WAIT_BAR(n2);} }while(0)
  const int vb0=(int)(lds0+LDS_V)+((lane>>4)&1)*32+(lane&3)*8+(4*hi+((lane&15)>>2))*64;
  const char*Kbase=shm+LDS_K; bf16x8 kf[8];
  const lds_cptr shm3=(lds_cptr)shm; const lds_cptr kp0=shm3+LDS_K+hi*1024+r32*16; const lds_cptr vp0=shm3+LDS_V+((lane>>4)&1)*32+(lane&3)*8+(4*hi+((lane&15)>>2))*64;
  if(wid>=4)__builtin_amdgcn_s_setprio(1);
  DMA_K(0,0);DMA_V(0,0);DMA_K(1,SLOTB);
  bf16x8 qr[4];
  #pragma unroll
  for(int d0=0;d0<4;++d0)qr[d0]=*reinterpret_cast<const bf16x8*>(&Qw[(long)r32*QP+d0*16+hi*8]);
  float mhat=0.f,l_reg=0.f;f32x16 o[NVQ];
  #pragma unroll
  for(int d_=0;d_<NVQ;++d_)o[d_]=f32x16{};
  f32x16 negm=f32x16{};asm volatile("":"+v"(negm));
  #define CMASK(P0,P1,t) do{}while(0)
  bool resc=false;
  #define START(P0,P1) do{ const float rm=rowmax(P0,P1); resc=false; \
    { const float dl=rm; mhat=fadd_s(mhat,dl); \
      _Pragma("unroll") for(int r=0;r<16;++r){P0[r]=fsub_s(P0[r],dl);P1[r]=fsub_s(P1[r],dl);} \
      _Pragma("unroll") for(int r=0;r<16;++r)negm[r]=-mhat; asm volatile("":"+v"(negm)); } \
    _Pragma("unroll") for(int r=0;r<16;++r)P0[r]=__builtin_amdgcn_exp2f(P0[r]); }while(0)
  #define RESC() do{ if(resc){ asm volatile("s_waitcnt lgkmcnt(0)":::"memory"); \
      _Pragma("unroll") for(int d_=0;d_<NVQ;++d_) _Pragma("unroll") for(int r=0;r<16;++r)o[d_][r]*=wsf[crow(r,hi)]; } }while(0)
  f32x16 pA0,pA1,pB0,pB1;
  int sl_prev=0,sl_cur=0,sl_next=SLOTB;
  #define ROT() do{sl_prev=sl_cur;sl_cur=sl_next;sl_next=(sl_next==(NSLOT-1)*SLOTB)?0:sl_next+SLOTB;}while(0)
  DMA_K(2,2*SLOTB);
  WAITB(3,4);
  qkt(pA0,pA1,Kbase,qr,negm,r32,hi);asm volatile("s_nop 15\n\ts_nop 7":"+v"(pA0),"+v"(pA1));CMASK(pA0,pA1,0);
  START(pA0,pA1);
  _Pragma("unroll") for(int r=0;r<16;++r)pA1[r]=__builtin_amdgcn_exp2f(pA1[r]);
  WAIT_BAR(0);
  DMA_K(3,0);DMA_V(1,SLOTB);
  ROT();
  kload8(kf,kp0+sl_cur);
  WAITB(2,3);
  s16x4 vlo[8],vhi[8]; u32x4 pw0,pw1,pw2,pw3;
  #define PKW(P,B) cvtpk_s(P[B],P[B+1])
  #define PAF(k) __builtin_bit_cast(bf16x8,pw##k)
  #define VFR(i) (bf16x8){vlo[i][0],vlo[i][1],vlo[i][2],vlo[i][3],vhi[i][0],vhi[i][1],vhi[i][2],vhi[i][3]}
  #define PIN(x) asm volatile("":"+v"(x))
  #define MX3(a,b,c) __builtin_fmaxf(__builtin_fmaxf((a),(b)),(c))
  #define GAPA(MF,A0,A1,A2,A3,W0,W1,PW) do{ MF; sacc+=A0; sacc+=A1; sacc+=A2; sacc+=A3; PIN(sacc); W0; W1; PIN(PW); SBAR(); }while(0)
  #define EX(v) __builtin_amdgcn_exp2f(v)
  #define GAPB(MF,X,B) do{ MF; X[B]=EX(X[B]); X[B+1]=EX(X[B+1]); X[B+2]=EX(X[B+2]); X[B+3]=EX(X[B+3]); PIN(X); SBAR(); }while(0)
  #define VRD(i) do{ vlo[i]=vtr(vp_+(((i)>>2)*4096+((i)&3)*1024)); vhi[i]=vtr(vp_+(((i)>>2)*4096+((i)&3)*1024+512)); }while(0)
  #define GAPB2(MF,X,B) do{ MF; X[B]=EX(X[B]); X[B+1]=EX(X[B+1]); PIN(X); SBAR(); }while(0)
  #define VRF(r,i) do{ vlo[r]=vtr(vp_+(((i)>>2)*4096+((i)&3)*1024)); vhi[r]=vtr(vp_+(((i)>>2)*4096+((i)&3)*1024+512)); }while(0)
  #define VRD2(i) do{ vlo[i]=vtr(vp_+(8192+((i)>>2)*4096+((i)&3)*1024)); vhi[i]=vtr(vp_+(8192+((i)>>2)*4096+((i)&3)*1024+512)); }while(0)
  #define KRD(G,j) do{ if(G){ kload2(kf,kp0+sl_next,j); SBAR(); } }while(0)
  #define STEP(C0,C1,P0,P1,t,GK,GV,GL) do{ SBAR(); \
    const lds_cptr vp_=vp0+2*sl_prev; \
    VRD(0); SBAR(); float sacc=(P0[0]+P0[1]); \
    GAPA(C0=__builtin_amdgcn_mfma_f32_32x32x16_bf16(kf[0],qr[0],negm,0,0,0), P0[2],P0[3],P0[4],P0[5],     pw0[0]=PKW(P0,0), pw0[1]=PKW(P0,2), pw0); \
    VRD(4); SBAR(); GAPA(C1=__builtin_amdgcn_mfma_f32_32x32x16_bf16(kf[1],qr[0],negm,0,0,0), P0[6],P0[7],P0[8],P0[9],     pw0[2]=PKW(P0,4), pw0[3]=PKW(P0,6), pw0); \
    VRD(1); SBAR(); GAPA(C0=__builtin_amdgcn_mfma_f32_32x32x16_bf16(kf[2],qr[1],C0,0,0,0),   P0[10],P0[11],P0[12],P0[13], pw1[0]=PKW(P0,8), pw1[1]=PKW(P0,10), pw1); \
    VRD(5); SBAR(); GAPA(C1=__builtin_amdgcn_mfma_f32_32x32x16_bf16(kf[3],qr[1],C1,0,0,0),   P0[14],P0[15],P1[0],P1[1],   pw1[2]=PKW(P0,12),pw1[3]=PKW(P0,14), pw1); \
    VRD(2); SBAR(); GAPA(C0=__builtin_amdgcn_mfma_f32_32x32x16_bf16(kf[4],qr[2],C0,0,0,0),   P1[2],P1[3],P1[4],P1[5],     pw2[0]=PKW(P1,0), pw2[1]=PKW(P1,2), pw2); \
    VRD(6); SBAR(); GAPA(C1=__builtin_amdgcn_mfma_f32_32x32x16_bf16(kf[5],qr[2],C1,0,0,0),   P1[6],P1[7],P1[8],P1[9],     pw2[2]=PKW(P1,4), pw2[3]=PKW(P1,6), pw2); \
    VRD(3); SBAR(); GAPA(C0=__builtin_amdgcn_mfma_f32_32x32x16_bf16(kf[6],qr[3],C0,0,0,0),   P1[10],P1[11],P1[12],P1[13], pw3[0]=PKW(P1,8), pw3[1]=PKW(P1,10), pw3); \
    VRD(7); SBAR(); GAPA(C1=__builtin_amdgcn_mfma_f32_32x32x16_bf16(kf[7],qr[3],C1,0,0,0),   P1[14],P1[15],0.f,0.f,       pw3[2]=PKW(P1,12),pw3[3]=PKW(P1,14), pw3); \
    l_reg+=sacc; \
    if(GK){DMA_K((t)+3,sl_cur);} if(GV){DMA_V((t)+1,sl_next);} \
    CMASK(C0,C1,t); \
    { float a=MX3(C0[0],C0[1],C1[0]),b=MX3(C0[2],C0[3],C1[1]); a=MX3(a,C1[2],C1[3]); \
      _Pragma("unroll") for(int r=4;r<16;r+=4){a=MX3(a,C0[r],C0[r+1]);b=MX3(b,C0[r+2],C0[r+3]);a=MX3(a,C1[r],C1[r+1]);b=MX3(b,C1[r+2],C1[r+3]);} \
      float rm=__builtin_fmaxf(a,b); { auto rr=__builtin_amdgcn_permlane32_swap(__float_as_uint(rm),__float_as_uint(rm),false,false); rm=__builtin_fmaxf(__uint_as_float(rr[0]),__uint_as_float(rr[1])); } \
      resc=false; \
      if(__builtin_expect(__any(rm>(float)THRL),0)){ const float dl=__builtin_fmaxf(rm,0.f); mhat+=dl; \
        _Pragma("unroll") for(int r=0;r<16;++r){C0[r]-=dl;C1[r]-=dl;} \
        _Pragma("unroll") for(int r=0;r<16;++r)negm[r]=-mhat; asm volatile("":"+v"(negm)); \
        const float f=__builtin_amdgcn_exp2f(-dl); l_reg*=f; if(hi==0)wsf[r32]=f; resc=true; } } \
    SBAR(); \
    GAPB(o[0]=__builtin_amdgcn_mfma_f32_32x32x16_bf16(PAF(0),VFR(0),o[0],0,0,0), C0,0); \
    GAPB(o[1]=__builtin_amdgcn_mfma_f32_32x32x16_bf16(PAF(0),VFR(4),o[1],0,0,0), C0,4); \
    KRD(GL,0); GAPB(o[0]=__builtin_amdgcn_mfma_f32_32x32x16_bf16(PAF(1),VFR(1),o[0],0,0,0), C0,8); \
    KRD(GL,1); GAPB(o[1]=__builtin_amdgcn_mfma_f32_32x32x16_bf16(PAF(1),VFR(5),o[1],0,0,0), C0,12); \
    KRD(GL,2); GAPB(o[0]=__builtin_amdgcn_mfma_f32_32x32x16_bf16(PAF(2),VFR(2),o[0],0,0,0), C1,0); \
    KRD(GL,3); GAPB(o[1]=__builtin_amdgcn_mfma_f32_32x32x16_bf16(PAF(2),VFR(6),o[1],0,0,0), C1,4); \
    GAPB(o[0]=__builtin_amdgcn_mfma_f32_32x32x16_bf16(PAF(3),VFR(3),o[0],0,0,0), C1,8); \
    GAPB(o[1]=__builtin_amdgcn_mfma_f32_32x32x16_bf16(PAF(3),VFR(7),o[1],0,0,0), C1,12); \
    }while(0)
  #define STEP4(C0,C1,P0,P1,t,GK,GV,GL) do{ SBAR(); \
    const lds_cptr vp_=vp0+2*sl_prev; \
    float sacc=(P0[0]+P0[1]); \
    GAPA(C0=__builtin_amdgcn_mfma_f32_32x32x16_bf16(kf[0],qr[0],negm,0,0,0), P0[2],P0[3],P0[4],P0[5],     pw0[0]=PKW(P0,0), pw0[1]=PKW(P0,2), pw0); \
    GAPA(C1=__builtin_amdgcn_mfma_f32_32x32x16_bf16(kf[1],qr[0],negm,0,0,0), P0[6],P0[7],P0[8],P0[9],     pw0[2]=PKW(P0,4), pw0[3]=PKW(P0,6), pw0); \
    GAPA(C0=__builtin_amdgcn_mfma_f32_32x32x16_bf16(kf[2],qr[1],C0,0,0,0),   P0[10],P0[11],P0[12],P0[13], pw1[0]=PKW(P0,8), pw1[1]=PKW(P0,10), pw1); \
    GAPA(C1=__builtin_amdgcn_mfma_f32_32x32x16_bf16(kf[3],qr[1],C1,0,0,0),   P0[14],P0[15],P1[0],P1[1],   pw1[2]=PKW(P0,12),pw1[3]=PKW(P0,14), pw1); \
    VRF(0,0); SBAR(); GAPA(C0=__builtin_amdgcn_mfma_f32_32x32x16_bf16(kf[4],qr[2],C0,0,0,0),   P1[2],P1[3],P1[4],P1[5],     pw2[0]=PKW(P1,0), pw2[1]=PKW(P1,2), pw2); \
    VRF(1,4); SBAR(); GAPA(C1=__builtin_amdgcn_mfma_f32_32x32x16_bf16(kf[5],qr[2],C1,0,0,0),   P1[6],P1[7],P1[8],P1[9],     pw2[2]=PKW(P1,4), pw2[3]=PKW(P1,6), pw2); \
    VRF(2,8); SBAR(); GAPA(C0=__builtin_amdgcn_mfma_f32_32x32x16_bf16(kf[6],qr[3],C0,0,0,0),   P1[10],P1[11],P1[12],P1[13], pw3[0]=PKW(P1,8), pw3[1]=PKW(P1,10), pw3); \
    VRF(3,12); SBAR(); GAPA(C1=__builtin_amdgcn_mfma_f32_32x32x16_bf16(kf[7],qr[3],C1,0,0,0),   P1[14],P1[15],0.f,0.f,       pw3[2]=PKW(P1,12),pw3[3]=PKW(P1,14), pw3); \
    l_reg+=sacc; \
    if(GK){DMA_K((t)+3,sl_cur);} if(GV){DMA_V((t)+1,sl_next);} \
    CMASK(C0,C1,t); \
    { float a=MX3(C0[0],C0[1],C1[0]),b=MX3(C0[2],C0[3],C1[1]); a=MX3(a,C1[2],C1[3]); \
      _Pragma("unroll") for(int r=4;r<16;r+=4){a=MX3(a,C0[r],C0[r+1]);b=MX3(b,C0[r+2],C0[r+3]);a=MX3(a,C1[r],C1[r+1]);b=MX3(b,C1[r+2],C1[r+3]);} \
      float rm=__builtin_fmaxf(a,b); { auto rr=__builtin_amdgcn_permlane32_swap(__float_as_uint(rm),__float_as_uint(rm),false,false); rm=__builtin_fmaxf(__uint_as_float(rr[0]),__uint_as_float(rr[1])); } \
      resc=false; \
      if(__builtin_expect(__any(rm>(float)THRL),0)){ const float dl=__builtin_fmaxf(rm,0.f); mhat+=dl; \
        _Pragma("unroll") for(int r=0;r<16;++r){C0[r]-=dl;C1[r]-=dl;} \
        _Pragma("unroll") for(int r=0;r<16;++r)negm[r]=-mhat; asm volatile("":"+v"(negm)); \
        const float f=__builtin_amdgcn_exp2f(-dl); l_reg*=f; if(hi==0)wsf[r32]=f; resc=true; } } \
    SBAR(); \
    GAPB2(o[0]=__builtin_amdgcn_mfma_f32_32x32x16_bf16(PAF(0),VFR(0),o[0],0,0,0), C0,0); VRF(0,1); SBAR(); \
    GAPB2(o[1]=__builtin_amdgcn_mfma_f32_32x32x16_bf16(PAF(0),VFR(1),o[1],0,0,0), C0,2); VRF(1,5); SBAR(); \
    GAPB2(o[2]=__builtin_amdgcn_mfma_f32_32x32x16_bf16(PAF(0),VFR(2),o[2],0,0,0), C0,4); VRF(2,9); SBAR(); \
    GAPB2(o[3]=__builtin_amdgcn_mfma_f32_32x32x16_bf16(PAF(0),VFR(3),o[3],0,0,0), C0,6); VRF(3,13); SBAR(); \
    GAPB2(o[0]=__builtin_amdgcn_mfma_f32_32x32x16_bf16(PAF(1),VFR(0),o[0],0,0,0), C0,8); VRF(0,2); SBAR(); \
    GAPB2(o[1]=__builtin_amdgcn_mfma_f32_32x32x16_bf16(PAF(1),VFR(1),o[1],0,0,0), C0,10); VRF(1,6); SBAR(); \
    GAPB2(o[2]=__builtin_amdgcn_mfma_f32_32x32x16_bf16(PAF(1),VFR(2),o[2],0,0,0), C0,12); VRF(2,10); SBAR(); \
    GAPB2(o[3]=__builtin_amdgcn_mfma_f32_32x32x16_bf16(PAF(1),VFR(3),o[3],0,0,0), C0,14); VRF(3,14); SBAR(); \
    KRD(GL,0); GAPB2(o[0]=__builtin_amdgcn_mfma_f32_32x32x16_bf16(PAF(2),VFR(0),o[0],0,0,0), C1,0); VRF(0,3); SBAR(); \
    GAPB2(o[1]=__builtin_amdgcn_mfma_f32_32x32x16_bf16(PAF(2),VFR(1),o[1],0,0,0), C1,2); VRF(1,7); SBAR(); \
    KRD(GL,1); GAPB2(o[2]=__builtin_amdgcn_mfma_f32_32x32x16_bf16(PAF(2),VFR(2),o[2],0,0,0), C1,4); VRF(2,11); SBAR(); \
    GAPB2(o[3]=__builtin_amdgcn_mfma_f32_32x32x16_bf16(PAF(2),VFR(3),o[3],0,0,0), C1,6); VRF(3,15); SBAR(); \
    KRD(GL,2); GAPB2(o[0]=__builtin_amdgcn_mfma_f32_32x32x16_bf16(PAF(3),VFR(0),o[0],0,0,0), C1,8); \
    GAPB2(o[1]=__builtin_amdgcn_mfma_f32_32x32x16_bf16(PAF(3),VFR(1),o[1],0,0,0), C1,10); \
    KRD(GL,3); GAPB2(o[2]=__builtin_amdgcn_mfma_f32_32x32x16_bf16(PAF(3),VFR(2),o[2],0,0,0), C1,12); \
    GAPB2(o[3]=__builtin_amdgcn_mfma_f32_32x32x16_bf16(PAF(3),VFR(3),o[3],0,0,0), C1,14); \
    }while(0)
  #define STEPX(C0,C1,P0,P1,t,GK,GV,GL) do{ if constexpr(NVQ==4){ STEP4(C0,C1,P0,P1,t,GK,GV,GL); } else { STEP(C0,C1,P0,P1,t,GK,GV,GL); } }while(0)
  int t=1;
  #undef CMASK
  #define CMASK(P0,P1,t) do{}while(0)
  for(;t+5<NT;t+=2){
    STEPX(pB0,pB1,pA0,pA1,t,true,true,true);     WAITB(2,3); RESC(); ROT();
    STEPX(pA0,pA1,pB0,pB1,t+1,true,true,true);   WAITB(2,3); RESC(); ROT();
  }
  #undef CMASK
  #define CMASK(P0,P1,t) do{}while(0)
  #define ENDW(tt) do{ if((tt)+3<NT){WAITB(2,3);} else if((tt)+2<NT){WAITB(1,2);} else {WAIT_BAR(0);} }while(0)
  for(;t+1<NT;t+=2){
    STEPX(pB0,pB1,pA0,pA1,t,(t+3<NT),(t+1<NT),(t+1<NT));       ENDW(t);   RESC(); ROT();
    STEPX(pA0,pA1,pB0,pB1,t+1,(t+4<NT),(t+2<NT),(t+2<NT));     ENDW(t+1); RESC(); ROT();
  }
  STEPX(pB0,pB1,pA0,pA1,NT-1,false,false,false); RESC();
  { float sacc=pB0[0]+pB0[1]; _Pragma("unroll") for(int r=2;r<16;++r)sacc+=pB0[r]; _Pragma("unroll") for(int r=0;r<16;++r)sacc+=pB1[r]; l_reg+=sacc;
    pw0=(u32x4){PKW(pB0,0),PKW(pB0,2),PKW(pB0,4),PKW(pB0,6)};pw1=(u32x4){PKW(pB0,8),PKW(pB0,10),PKW(pB0,12),PKW(pB0,14)};pw2=(u32x4){PKW(pB1,0),PKW(pB1,2),PKW(pB1,4),PKW(pB1,6)};pw3=(u32x4){PKW(pB1,8),PKW(pB1,10),PKW(pB1,12),PKW(pB1,14)};
    SBAR(); pv<NVQ>(o,vb0+2*sl_cur,PAF(0),PAF(1),PAF(2),PAF(3)); }
  #undef PKW
  #undef PAF
  #undef VFR
  #undef PIN
  #undef MX3
  #undef GAPA
  #undef GAPB
  #undef GAPB2
  #undef VRD2
  #undef EX
  #undef VRD
  #undef KRD
  #undef STEP
  #undef STEP4
  #undef STEPX
  #undef VRF
  #undef ENDW
  { int lane_e=lane; asm volatile("":"+v"(lane_e)); const int r32=lane_e&31,hi=lane_e>>5,lane=lane_e;
  {auto rr=__builtin_amdgcn_permlane32_swap(__float_as_uint(l_reg),__float_as_uint(l_reg),false,false);l_reg=__uint_as_float(rr[0])+__uint_as_float(rr[1]);}
  if(hi==0)wsf[32+r32]=l_reg;asm volatile("s_waitcnt lgkmcnt(0)":::"memory");
  float rli[16];
  #pragma unroll
  for(int r=0;r<16;++r)rli[r]=__builtin_amdgcn_rcpf(wsf[32+crow(r,hi)]);
  if(MODE==0){
    bf16*Ow=Odst+(long)(wid*QBLK)*1024;
    bf16*stg=(bf16*)(shm+LDS_OST)+wid*4096;
    #pragma unroll
    for(int r=0;r<16;++r){const int orow=crow(r,hi);
      #pragma unroll
      for(int d0=0;d0<2;++d0)stg[orow*64+d0*32+r32]=__float2bfloat16(o[d0][r]*rli[r]);}
    asm volatile("s_waitcnt lgkmcnt(0)":::"memory");
    #pragma unroll
    for(int i=0;i<4;++i){const int row=i*8+(lane>>3),ch=lane&7; const u32x4 v=*(const u32x4*)(stg+row*64+ch*8); ATTN_STORE16(Ow+(long)row*1024+ch*8,v);}
  } else {
    bf16*stg=(bf16*)(shm+LDS_OST)+wid*4096+ecol;
    #pragma unroll
    for(int r=0;r<16;++r){const int orow=crow(r,hi);
      #pragma unroll
      for(int d0=0;d0<NVQ;++d0){ float val=o[d0][r]*rli[r];
        if(MODE==2){ val=__bfloat162float(stg[orow*128+d0*32+r32])-lam*val; }
        stg[orow*128+d0*32+r32]=__float2bfloat16(val);} }
  }
  }
  __builtin_amdgcn_s_setprio(0);
  asm volatile("s_waitcnt lgkmcnt(0)\n\ts_barrier":::"memory");
  #undef DMA_K
  #undef DMA_V
  #undef WAITB
  #undef CMASK
  #undef START
  #undef RESC
  #undef ROT
}
constexpr int ATTN_LDS_BYTES=LDS_BYTES;

struct AttnArgs { const bf16* QB; const bf16* KB; const bf16* VB; bf16* OB; const float* subln; float lam; };
template<int THRL> __device__ __forceinline__ void attn_unit(const AttnArgs&A,int qrow0,int krow0,int NT,int isdiff,int head,char*shm){
  int tid_=threadIdx.x; asm volatile("":"+v"(tid_)); const int tid=tid_,lane=tid&63; const int wid=__builtin_amdgcn_readfirstlane(tid>>6);
  const int qcol=isdiff?head*128:512+head*64, kcol=isdiff?head*128:512+(head>>2)*64;
  const bf16*Qb=A.QB+(long)qrow0*1024+qcol; const bf16*Kb=A.KB+(long)krow0*640+kcol; const bf16*Vb=A.VB+(long)krow0*640+kcol;
  bf16*Ob=A.OB+(long)qrow0*1024+qcol;
  if(isdiff){
    for(int mp=0;mp<2;++mp) attn_pass<THRL,1024,640,4>(Qb+mp*64,Kb+mp*64,Vb,NT,Ob,0,A.lam,1+mp,shm);
  } else {
    attn_pass<THRL,1024,640,2>(Qb,Kb,Vb,NT,Ob,0,A.lam,0,shm);
  }
  if(isdiff){
    int lane_e=lane; asm volatile("":"+v"(lane_e));
    const bf16*stg=(const bf16*)(shm+LDS_OST)+wid*4096; bf16*Ow=Ob+(long)(wid*QBLK)*1024; const int ch=lane_e&15;
    float g[8];
    #pragma unroll
    for(int k=0;k<8;++k)g[k]=A.subln[ch*8+k]*0.8f;
    #pragma unroll
    for(int i=0;i<8;++i){ const int row=i*4+(lane_e>>4); const u32x4 v=*(const u32x4*)(stg+row*128+ch*8);
      float f[8];
      #pragma unroll
      for(int k=0;k<4;++k){f[2*k]=__uint_as_float(v[k]<<16);f[2*k+1]=__uint_as_float(v[k]&0xffff0000u);}
      float ss=0.f;
      #pragma unroll
      for(int k=0;k<8;++k)ss+=f[k]*f[k];
      ss+=__shfl_xor(ss,1);ss+=__shfl_xor(ss,2);ss+=__shfl_xor(ss,4);ss+=__shfl_xor(ss,8);
      const float rs=1.0f/sqrtf(ss*(1.0f/128.0f)+1e-6f);
      u32x4 w; w.x=cvtpk_s(f[0]*rs*g[0],f[1]*rs*g[1]); w.y=cvtpk_s(f[2]*rs*g[2],f[3]*rs*g[3]); w.z=cvtpk_s(f[4]*rs*g[4],f[5]*rs*g[5]); w.w=cvtpk_s(f[6]*rs*g[6],f[7]*rs*g[7]);
      *(u32x4*)(Ow+(long)row*1024+ch*8)=w; }
    asm volatile("s_waitcnt lgkmcnt(0)":::"memory");
  }
}
template<int THRL=8> __device__ __forceinline__ void attn_phase(char*lds,const AttnArgs&A,int vcu,int G){
  for(int s=vcu;s<1280;s+=G){
    const int j=s>>8,r=s&255; int qrow0,krow0,NT,isdiff,head;
    if(j==0){ qrow0=8192+(r>>6)*4096+(r&15)*256; krow0=8192+(r>>6)*4608; NT=72; isdiff=1; head=(r>>4)&3; }
    else if(j<=2){ const int u=2*r+(j-1); qrow0=8192+(u>>7)*4096+(u&15)*256; krow0=8192+(u>>7)*4608; NT=72; isdiff=0; head=(u>>4)&7; }
    else if(j==3){ if(r<128){ qrow0=(r>>2)*256; krow0=qrow0; NT=4; isdiff=1; head=r&3; } else { const int u=r-128; qrow0=(u>>3)*256; krow0=qrow0; NT=4; isdiff=0; head=u&7; } }
    else { if(r<128)continue; const int u=r; qrow0=(u>>3)*256; krow0=qrow0; NT=4; isdiff=0; head=u&7; }
    attn_unit<THRL>(A,qrow0,krow0,NT,isdiff,head,lds);
  }
}
#undef SBAR
#undef WAIT_BAR
}
#define GAS __attribute__((address_space(1)))
#define LAS __attribute__((address_space(3)))
typedef unsigned short bfu;
typedef unsigned v4u __attribute__((ext_vector_type(4)));
typedef unsigned v2u __attribute__((ext_vector_type(2)));
typedef float f32x4 __attribute__((ext_vector_type(4)));
#define LDS_WAIT() asm volatile("s_waitcnt lgkmcnt(0)" ::: "memory")
constexpr int NWAVES = 8, LDS_BYTES = 147456;
constexpr size_t MiB = 1u << 20;
constexpr size_t WS_MOD = 0, WS_BAR = 192 * 1024, WS_CTL_BYTES = 192 * 1024 + 16 * 1024, WS_ROPE = 256 * 1024, WS_WGU1 = 1 * MiB, WS_WD1 = 12 * MiB, WS_WIN = 18 * MiB, WS_WOUT = 23 * MiB, WS_WGU2 = 25 * MiB, WS_WD2 = 36 * MiB;
constexpr size_t WS_H = 42 * MiB, WS_ACT = 90 * MiB, WS_QB = 90 * MiB, WS_KB = 138 * MiB, WS_VB = 171 * MiB, WS_END = 222 * MiB;
constexpr int M_TOK = 24576, D_M = 1024, D_FF = 2816, D_IN = 2304, KVROWS = 26624, NMODV_ = 9216;
static_assert(WS_KB + (size_t)KVROWS * 640 * 2 <= WS_VB && WS_VB + (size_t)KVROWS * 640 * 2 <= WS_END && WS_ACT + (size_t)M_TOK * D_FF * 2 <= WS_END, "ws map");
constexpr int LDS_CTL = 143360;
static_assert(attn_body::ATTN_LDS_BYTES <= LDS_CTL && LDS_CTL + 1024 <= LDS_BYTES, "LDS map");

__device__ __forceinline__ unsigned pk2(float lo, float hi) { return pg8::cvt_pk_bf16(lo, hi); }
__device__ __forceinline__ float wave_sum(float v) {
#pragma unroll
    for (int o = 1; o < 64; o <<= 1) v += __shfl_xor(v, o);
    return v;
}
__device__ __forceinline__ void transpose_item(const float* W, int K, int N, bfu* WT, int kind, LAS float* scr, int item, int lane) {
    const int nblk = N / 32, kb = item / nblk, nb = item % nblk, k0 = 64 * kb, n0 = 32 * nb;
    int pr = n0;
    if (kind == 1) { const int L = n0 < D_FF ? n0 : n0 - D_FF; pr = 256 * (L / 128) + (L % 128) + (n0 < D_FF ? 0 : 128); }
    else if (kind == 2) { const int ch = n0 / 64, half = (n0 / 32) & 1; pr = 256 * (ch / 4) + 128 * half + 32 * (ch % 4); }
#pragma unroll 8
    for (int i = 0; i < 32; ++i) { const int kk = 2 * i + (lane >> 5); scr[kk * 33 + (lane & 31)] = __builtin_nontemporal_load(W + (size_t)(k0 + kk) * N + n0 + (lane & 31)); }
    LDS_WAIT(); asm volatile("" ::: "memory");
    const int c = lane & 7;
#pragma unroll
    for (int j = 0; j < 4; ++j) { const int n = (lane >> 3) + 8 * j; const LAS float* s = scr + (8 * c) * 33 + n;
        v4u o; o.x = pk2(s[0 * 33], s[1 * 33]); o.y = pk2(s[2 * 33], s[3 * 33]); o.z = pk2(s[4 * 33], s[5 * 33]); o.w = pk2(s[6 * 33], s[7 * 33]);
        *(GAS v4u*)(WT + (size_t)(pr + n) * K + k0 + 8 * c) = o; }
    LDS_WAIT(); asm volatile("" ::: "memory");
}
__device__ __forceinline__ void ada_item(const float* c, const float* c_ctx, const float* w_ada, const float* b_ada, float* mod, LAS float* scr, int item, int lane) {
    const int cb = item % 144, kc = item / 144, n = cb * 64 + lane, k0 = kc * 128;
#pragma unroll
    for (int i = 0; i < 10; ++i) { const int idx = lane + 64 * i, v = idx >> 7, kk = idx & 127; const float cv = v < 4 ? c[v * 1024 + k0 + kk] : c_ctx[k0 + kk]; scr[idx] = cv / (1.0f + expf(-cv)); }
    LDS_WAIT(); asm volatile("" ::: "memory");
    float acc[5] = {0.f, 0.f, 0.f, 0.f, 0.f};
#pragma unroll 8
    for (int kk = 0; kk < 128; ++kk) { const float w = __builtin_nontemporal_load(w_ada + (size_t)(k0 + kk) * NMODV_ + n);
#pragma unroll
        for (int v = 0; v < 5; ++v) acc[v] += scr[v * 128 + kk] * w; }
    const float bb = kc == 0 ? b_ada[n] : 0.f;
#pragma unroll
    for (int v = 0; v < 5; ++v) unsafeAtomicAdd(mod + v * NMODV_ + n, acc[v] + bb);
    LDS_WAIT(); asm volatile("" ::: "memory");
}
__device__ __forceinline__ float sumsq4(const f32x4 (&v)[4]) { float s = 0.f;
#pragma unroll
    for (int j = 0; j < 4; ++j) s += (v[j].x * v[j].x + v[j].y * v[j].y) + (v[j].z * v[j].z + v[j].w * v[j].w);
    return s; }
template <bool NTL> __device__ __forceinline__ void norm_mod_phase(const float* X0, const float* X1, const float* g, const float* mod, int shift_idx, bfu* H, int gw, int NGW, int lane_) {
    const int per = (M_TOK + NGW - 1) / NGW, per2 = (per + 1) & ~1, r0 = gw * per2, r1 = (r0 + per2 < M_TOK) ? r0 + per2 : M_TOK;
    if (r0 >= r1) return;
    const int lane = 4 * (lane_ & 15) + (lane_ >> 4), q_ = lane_ >> 4;
    f32x4 gm[4], sh[4]; int cur_mv = -1;
    f32x4 na[4], nb[4];
#define NRM_LD(p) (NTL ? __builtin_nontemporal_load(p) : *(p))
#define NRM_ROWP(m) ((m) < 8192 ? X0 + (size_t)(m) * D_M : X1 + (size_t)((m) - 8192) * D_M)
#pragma unroll
    for (int j = 0; j < 4; ++j) { na[j] = NRM_LD((const f32x4*)NRM_ROWP(r0) + lane + 64 * j); nb[j] = NRM_LD((const f32x4*)NRM_ROWP(r0 + 1) + lane + 64 * j); }
    for (int m = r0; m < r1; m += 2) {
        f32x4 va[4], vb[4];
#pragma unroll
        for (int j = 0; j < 4; ++j) { va[j] = na[j]; vb[j] = nb[j]; }
        if (m + 2 < r1) {
#pragma unroll
            for (int j = 0; j < 4; ++j) { na[j] = NRM_LD((const f32x4*)NRM_ROWP(m + 2) + lane + 64 * j); nb[j] = NRM_LD((const f32x4*)NRM_ROWP(m + 3) + lane + 64 * j); }
        }
#pragma unroll
        for (int half = 0; half < 2; ++half) {
            const int mm = m + half; const int mv = mm < 8192 ? 4 : ((mm - 8192) >> 12);
            if (mv != cur_mv) { cur_mv = mv; const f32x4* shp = (const f32x4*)(mod + mv * NMODV_ + shift_idx * D_M) + lane; const f32x4* gg = (const f32x4*)g + lane;
#pragma unroll
                for (int j = 0; j < 4; ++j) { sh[j] = shp[64 * j]; gm[j] = gg[64 * j] * (shp[256 + 64 * j] + 1.0f); } }
            const float rstd = 1.0f / sqrtf(wave_sum(half ? sumsq4(vb) : sumsq4(va)) * (1.0f / D_M) + 1e-6f);
            bfu* orow = H + (size_t)mm * D_M + 4 * ((q_ & 1) ? lane - 1 : lane);
#pragma unroll
            for (int jp = 0; jp < 2; ++jp) {
                const f32x4 xa = half ? vb[2 * jp] : va[2 * jp], xb = half ? vb[2 * jp + 1] : va[2 * jp + 1];
                const f32x4 ha = xa * rstd * gm[2 * jp] + sh[2 * jp], hb = xb * rstd * gm[2 * jp + 1] + sh[2 * jp + 1];
                unsigned a0 = pk2(ha.x, ha.y), a1 = pk2(ha.z, ha.w), b0 = pk2(hb.x, hb.y), b1 = pk2(hb.z, hb.w);
                { auto r = __builtin_amdgcn_permlane16_swap(a0, b0, false, false); a0 = r[0]; b0 = r[1]; }
                { auto r = __builtin_amdgcn_permlane16_swap(a1, b1, false, false); a1 = r[0]; b1 = r[1]; }
                v4u w; w.x = a0; w.y = a1; w.z = b0; w.w = b1; *(v4u*)(orow + 256 * (2 * jp + (q_ & 1))) = w; }
        }
    }
#undef NRM_ROWP
#undef NRM_LD
}
__device__ __forceinline__ void final_norm_phase(float* X, const float* g, int gw, int NGW, int lane) {
    const int per = (M_TOK + NGW - 1) / NGW, per2 = (per + 1) & ~1, r0 = gw * per2, r1 = (r0 + per2 < M_TOK) ? r0 + per2 : M_TOK;
    if (r0 >= r1) return;
    f32x4 gm[4], na[4], nb[4];
#pragma unroll
    for (int j = 0; j < 4; ++j) { gm[j] = ((const f32x4*)g + lane)[64 * j]; na[j] = ((const f32x4*)(X + (size_t)r0 * D_M) + lane)[64 * j]; nb[j] = ((const f32x4*)(X + (size_t)(r0 + 1) * D_M) + lane)[64 * j]; }
    for (int m = r0; m < r1; m += 2) {
        f32x4 va[4], vb[4];
#pragma unroll
        for (int j = 0; j < 4; ++j) { va[j] = na[j]; vb[j] = nb[j]; }
        if (m + 2 < r1) {
#pragma unroll
            for (int j = 0; j < 4; ++j) { na[j] = ((const f32x4*)(X + (size_t)(m + 2) * D_M) + lane)[64 * j]; nb[j] = ((const f32x4*)(X + (size_t)(m + 3) * D_M) + lane)[64 * j]; }
        }
        const float ra = 1.0f / sqrtf(wave_sum(sumsq4(va)) * (1.0f / D_M) + 1e-6f), rb = 1.0f / sqrtf(wave_sum(sumsq4(vb)) * (1.0f / D_M) + 1e-6f);
        f32x4* xa = (f32x4*)(X + (size_t)m * D_M) + lane; f32x4* xb = (f32x4*)(X + (size_t)(m + 1) * D_M) + lane;
#pragma unroll
        for (int j = 0; j < 4; ++j) { __builtin_nontemporal_store(va[j] * ra * gm[j], xa + 64 * j); __builtin_nontemporal_store(vb[j] * rb * gm[j], xb + 64 * j); }
    }
}
__device__ __forceinline__ void rope_entry(float* rope, int idx) {
    const int pos = idx >> 4, j = idx & 15;
    double inv = 1.0; for (int i = 0; i < j; ++i) inv *= 0.56234132519034908;
    const float angf = (float)pos * (float)inv;
    const double ang = (double)angf;
    const double kq = rint(ang * 0.63661977236758134);
    double r = fma(-kq, 1.5707963267341256, ang); r = fma(-kq, 6.0771005065061922e-11, r);
    const double r2 = r * r;
    const double sn = r * (1.0 + r2 * (-1.0 / 6 + r2 * (1.0 / 120 + r2 * (-1.0 / 5040 + r2 * (1.0 / 362880 + r2 * (-1.0 / 39916800 + r2 * (1.0 / 6227020800.0)))))));
    const double cs = 1.0 + r2 * (-0.5 + r2 * (1.0 / 24 + r2 * (-1.0 / 720 + r2 * (1.0 / 40320 + r2 * (-1.0 / 3628800 + r2 * (1.0 / 479001600 + r2 * (-1.0 / 87178291200.0)))))));
    const int q = ((int)kq) & 3;
    const double s_ = q == 0 ? sn : q == 1 ? cs : q == 2 ? -sn : -cs;
    const double c_ = q == 0 ? cs : q == 1 ? -sn : q == 2 ? -cs : sn;
    rope[idx] = (float)c_; rope[1024 + idx] = (float)s_;
}
__device__ __forceinline__ void cache_item(const float* cdk, const float* cdv, const float* cgk, const float* cgv, bfu* KB, bfu* VB, int item, int lane) {
    const int row = item >> 1, which = item & 1;
    const int lb = row >> 9, p = row & 511; const size_t drow = (size_t)(8192 + lb * 4608 + p) * 640;
    const float* sd = (which ? cdv : cdk) + (size_t)row * 512; const float* sg = (which ? cgv : cgk) + (size_t)row * 128; bfu* dst = (which ? VB : KB) + drow;
    { const f32x4 a = __builtin_nontemporal_load((const f32x4*)(sd + lane * 8)), b = __builtin_nontemporal_load((const f32x4*)(sd + lane * 8 + 4)); v4u w; w.x = pk2(a.x, a.y); w.y = pk2(a.z, a.w); w.z = pk2(b.x, b.y); w.w = pk2(b.z, b.w); *(v4u*)(dst + lane * 8) = w; }
    if (lane < 16) { const f32x4 a = *(const f32x4*)(sg + lane * 8), b = *(const f32x4*)(sg + lane * 8 + 4); v4u w; w.x = pk2(a.x, a.y); w.y = pk2(a.z, a.w); w.z = pk2(b.x, b.y); w.w = pk2(b.z, b.w); *(v4u*)(dst + 512 + lane * 8) = w; }
}

#define RLX_AGENT __ATOMIC_RELAXED, __HIP_MEMORY_SCOPE_AGENT
#define XB_TMO      128
#define XB_XCNT(j)  (256  + 64 * (j))
#define XB_XSUB(j)  (1280 + 64 * (j))
#define XB_XGEN(j)  (2304 + 64 * (j))
#define XB_TOP      3328
#define XB_TOPGEN   3392
#define XCD_BAR_WORDS 3456
#define XB_SPIN_CAP (1u << 18)

__device__ __forceinline__ unsigned xb_ld(unsigned* p)              { return __hip_atomic_load(p, __ATOMIC_RELAXED, __HIP_MEMORY_SCOPE_AGENT); }
__device__ __forceinline__ unsigned xb_add(unsigned* p, unsigned v) { return __hip_atomic_fetch_add(p, v, __ATOMIC_RELAXED, __HIP_MEMORY_SCOPE_AGENT); }
__device__ __forceinline__ unsigned xb_xcc_id() { return (unsigned)__builtin_amdgcn_s_getreg((3 << 11) | 20) & 0xFu; }
#define XB_SPIN(cond, bar) do { unsigned _sp = 0; while (cond) { __builtin_amdgcn_s_sleep(1); \
    if ((++_sp & 255u) == 0u) { if (xb_ld(&(bar)[XB_TMO])) break; if (_sp > XB_SPIN_CAP) { atomicAdd(&(bar)[XB_TMO], 1u); break; } } } } while (0)

struct XcdBarrier {
    unsigned* bar; unsigned x;
    volatile LAS unsigned* st;
};

__device__ __forceinline__ XcdBarrier xcd_barrier_post(unsigned* bar, volatile LAS unsigned* st) {
    XcdBarrier b; b.bar = bar; b.x = xb_xcc_id(); b.st = st;
    if (threadIdx.x == 0) (void)xb_add(&bar[XB_XCNT(b.x)], 1u);
    return b;
}
__device__ __forceinline__ void xcd_barrier_complete(unsigned* bar, unsigned x, unsigned& nloc, unsigned& nx) {
    const unsigned G = gridDim.x * gridDim.y * gridDim.z;
    unsigned sum, cnt, mine, sp = 0u;
    for (;;) {
        sum = 0u; cnt = 0u; mine = 0u;
#pragma unroll
        for (unsigned j = 0; j < 16; ++j) { const unsigned c = xb_ld(&bar[XB_XCNT(j)]); sum += c; cnt += (c > 0u) ? 1u : 0u; mine = (j == x) ? c : mine; }
        if (sum == G) break;
        __builtin_amdgcn_s_sleep(1);
        if ((++sp & 255u) == 0u) { if (xb_ld(&bar[XB_TMO])) break; if (sp > XB_SPIN_CAP) { atomicAdd(&bar[XB_TMO], 1u); break; } }
    }
    nloc = mine > 0u ? mine : 1u; nx = cnt > 0u ? cnt : 1u;
}

__device__ __forceinline__ void xcd_barrier(const XcdBarrier& b) {
    asm volatile("s_waitcnt vmcnt(0)" ::: "memory");
    __syncthreads();
    if (threadIdx.x == 0) {
        unsigned* bar = b.bar;
        __builtin_amdgcn_s_waitcnt(0);
        unsigned nloc = b.st[0], nx = b.st[1];
        if (nloc == 0u) { xcd_barrier_complete(bar, b.x, nloc, nx); b.st[0] = nloc; b.st[1] = nx; }
        const unsigned old = xb_add(&bar[XB_XSUB(b.x)], 1u);
        const unsigned gen = old / nloc;
        if (old + 1u == (gen + 1u) * nloc) {
            __builtin_amdgcn_fence(__ATOMIC_RELEASE, "agent");
            asm volatile("s_waitcnt vmcnt(0)" ::: "memory");
            const unsigned og = xb_add(&bar[XB_TOP], 1u);
            const unsigned tg = og / nx;
            if (og + 1u == (tg + 1u) * nx) xb_add(&bar[XB_TOPGEN], 1u);
            else XB_SPIN(xb_ld(&bar[XB_TOPGEN]) == tg, bar);
            __builtin_amdgcn_fence(__ATOMIC_ACQUIRE, "agent");
            xb_add(&bar[XB_XGEN(b.x)], 1u);
            asm volatile("s_waitcnt vmcnt(0)" ::: "memory");
        } else {
            XB_SPIN(xb_ld(&bar[XB_XGEN(b.x)]) == gen, bar);
            __builtin_amdgcn_fence(__ATOMIC_ACQUIRE, "agent");
            asm volatile("s_waitcnt vmcnt(0)" ::: "memory");
        }
    }
    __syncthreads();
}

struct Args { const float* in[27]; float* o_; unsigned char* w_; };
__global__ void __launch_bounds__(NWAVES * 64, 2) fwd_megakernel(Args a) {
    extern __shared__ __attribute__((aligned(16))) unsigned char lds[];
    cg::grid_group grid = cg::this_grid();
    int tid = threadIdx.x, lane = tid & 63; const int wave = __builtin_amdgcn_readfirstlane(tid >> 6);
#define REFRESH() do { tid = threadIdx.x; asm volatile("" : "+v"(tid)); lane = tid & 63; gw = bx * NWAVES + wave; } while (0)
    const int G = gridDim.x, bx = blockIdx.x; const int vcu = (G % 8 == 0) ? (bx % 8) * (G / 8) + bx / 8 : bx;
    int gw = bx * NWAVES + wave; const int NGW = G * NWAVES;
#define ws (a.w_)
#define mod ((float*)(a.w_ + WS_MOD))
#define rope ((float*)(a.w_ + WS_ROPE))
#define WGU1 ((bfu*)(a.w_ + WS_WGU1))
#define WD1 ((bfu*)(a.w_ + WS_WD1))
#define WIN ((bfu*)(a.w_ + WS_WIN))
#define WOUT ((bfu*)(a.w_ + WS_WOUT))
#define WGU2 ((bfu*)(a.w_ + WS_WGU2))
#define WD2 ((bfu*)(a.w_ + WS_WD2))
#define H ((bfu*)(a.w_ + WS_H))
#define ACT ((bfu*)(a.w_ + WS_ACT))
#define QB ((bfu*)(a.w_ + WS_QB))
#define KB ((bfu*)(a.w_ + WS_KB))
#define VB ((bfu*)(a.w_ + WS_VB))
#define OB ((bfu*)(a.w_ + WS_H))
#define out (a.o_)
    PG8_LAS unsigned char* l3 = (PG8_LAS unsigned char*)lds;
    if (tid < 64) ((LAS unsigned*)(l3 + LDS_CTL))[tid] = 0u;
    __syncthreads();
    if (a.o_ == nullptr) grid.sync();
    XcdBarrier bar = xcd_barrier_post((unsigned*)(ws + WS_BAR), (volatile LAS unsigned*)(l3 + LDS_CTL));
#ifdef PROBE_A
    volatile LAS unsigned long long* stamps = (volatile LAS unsigned long long*)(l3 + LDS_CTL + 256); int n_stamp = 0;
#define STAMP() do { if (bx == 0 && tid == 0) stamps[n_stamp] = __builtin_amdgcn_s_memrealtime(); ++n_stamp; } while (0)
#else
#define STAMP() do {} while (0)
#endif
    STAMP();

    {
        LAS float* scr = (LAS float*)(l3 + wave * 16384);
        constexpr int I_GU = 16 * 176, I_DN = 44 * 32, I_IN = 16 * 72, I_OUT = 16 * 32, I_ADA = 1152;
        constexpr int NITEMS = I_GU + I_ADA;
        for (int it = gw; it < NITEMS; it += NGW) {
            int r = it;
            if (r < I_ADA) { ada_item(a.in[2], a.in[7], a.in[8], a.in[9], mod, scr, r, lane); continue; } r -= I_ADA;
            transpose_item(a.in[11], D_M, 2 * D_FF, WGU1, 1, scr, r, lane);
        }
        const int gt = bx * 512 + tid; if (gt < 1024) rope_entry(rope, gt);
    }
    xcd_barrier(bar); STAMP(); REFRESH();
    norm_mod_phase<true>(a.in[0], a.in[1], a.in[10], mod, 0, H, gw, NGW, lane);
    xcd_barrier(bar); STAMP(); REFRESH();
#ifndef NO_P2
    { pg8::Gemm g{H, WGU1, M_TOK, 2 * D_FF, D_M}; pg8::StaticOrder S; S.init(M_TOK, 2 * D_FF, G, bx); pg8::EpiSwiglu E{ACT};
      pg8::gemm_phase<pg8::EpiSwiglu, pg8::StaticOrder, true, true>(l3, g, S, E); }
#endif
    {
        constexpr int I_DN = 44 * 32, I_IN = 16 * 72, NIT1 = I_DN + I_IN;
        const int nun = (M_TOK / 256) * (2 * D_FF / 256), R_ = nun % G, busy = (R_ > 0 && 2 * R_ <= G) ? 2 * R_ : R_, first = busy, nhelp = busy == 0 ? G : G - busy;
        if (bx >= first) { LAS float* scr = (LAS float*)(l3 + wave * 16384);
            for (int it = (bx - first) * NWAVES + wave; it < NIT1; it += nhelp * NWAVES) {
                if (it < I_DN) transpose_item(a.in[12], D_FF, D_M, WD1, 0, scr, it, lane); else transpose_item(a.in[14], D_M, D_IN, WIN, 2, scr, it - I_DN, lane); } }
    }
    xcd_barrier(bar); STAMP(); REFRESH();
#ifndef NO_P3
    { pg8::Gemm g{ACT, WD1, M_TOK, D_M, D_FF}; pg8::StaticOrder S; S.init(M_TOK, D_M, G, bx); pg8::EpiResidT<true> E{a.in[0], a.in[1] - (size_t)8192 * D_M, out, mod, 2, 0.5f};
      pg8::gemm_phase<pg8::EpiResidT<true>, pg8::StaticOrder, true, true>(l3, g, S, E); }
#endif
    xcd_barrier(bar); STAMP(); REFRESH();
    norm_mod_phase<false>(out, out + (size_t)8192 * D_M, a.in[13], mod, 3, H, gw, NGW, lane);
    for (int it = gw; it < 4096; it += NGW) cache_item(a.in[3], a.in[4], a.in[5], a.in[6], KB, VB, it, lane);
    {
        constexpr int I_GU = 16 * 176, I_DN = 44 * 32, I_OUT = 16 * 32, NIT2 = I_OUT + I_GU + I_DN; LAS float* scr = (LAS float*)(l3 + wave * 16384);
        for (int it = gw; it < NIT2; it += NGW) { int r = it;
            if (r < I_OUT) { transpose_item(a.in[22], D_M, D_M, WOUT, 0, scr, r, lane); continue; } r -= I_OUT;
            if (r < I_GU) { transpose_item(a.in[24], D_M, 2 * D_FF, WGU2, 1, scr, r, lane); continue; } r -= I_GU;
            transpose_item(a.in[25], D_FF, D_M, WD2, 0, scr, r, lane); }
    }
    xcd_barrier(bar); STAMP(); REFRESH();
#ifndef NO_P5
    { pg8::Gemm g{H, WIN, M_TOK, D_IN, D_M}; pg8::StaticOrder S; S.init(M_TOK, D_IN, G, bx); pg8::EpiQKV E{QB, KB, VB, out, a.in[15], a.in[16], rope};
      pg8::gemm_phase<pg8::EpiQKV, pg8::StaticOrder, true, true>(l3, g, S, E); }
#endif
    xcd_barrier(bar); STAMP(); REFRESH();
    {
        const float p1 = wave_sum(a.in[17][lane] * a.in[18][lane]), p2 = wave_sum(a.in[19][lane] * a.in[20][lane]);
        const float lam = expf(p1) - expf(p2) + 0.2f;
        attn_body::AttnArgs A{(const attn_body::bf16*)QB, (const attn_body::bf16*)KB, (const attn_body::bf16*)VB, (attn_body::bf16*)OB, a.in[21], lam};
#ifndef NO_ATTN
        attn_body::attn_phase<8>((char*)lds, A, vcu, G);
#endif
    }
    xcd_barrier(bar); STAMP(); REFRESH();
#ifndef NO_P7
    { pg8::Gemm g{OB, WOUT, M_TOK, D_M, D_M}; pg8::StaticOrder S; S.init(M_TOK, D_M, G, bx); pg8::EpiResidT<false> E{out, out, out, mod, 5, 1.0f};
      pg8::gemm_phase<pg8::EpiResidT<false>, pg8::StaticOrder, true, true>(l3, g, S, E); }
#endif
    xcd_barrier(bar); STAMP(); REFRESH();
    norm_mod_phase<false>(out, out + (size_t)8192 * D_M, a.in[23], mod, 6, H, gw, NGW, lane);
    xcd_barrier(bar); STAMP(); REFRESH();
#ifndef NO_P9
    { pg8::Gemm g{H, WGU2, M_TOK, 2 * D_FF, D_M}; pg8::StaticOrder S; S.init(M_TOK, 2 * D_FF, G, bx); pg8::EpiSwiglu E{ACT};
      pg8::gemm_phase<pg8::EpiSwiglu, pg8::StaticOrder, true, true>(l3, g, S, E); }
#endif
    xcd_barrier(bar); STAMP(); REFRESH();
#ifndef NO_P10
    { pg8::Gemm g{ACT, WD2, M_TOK, D_M, D_FF}; pg8::StaticOrder S; S.init(M_TOK, D_M, G, bx); pg8::EpiResidT<false> E{out, out, out, mod, 8, 0.5f};
      pg8::gemm_phase<pg8::EpiResidT<false>, pg8::StaticOrder, true, true>(l3, g, S, E); }
#endif
    xcd_barrier(bar); STAMP(); REFRESH();
    final_norm_phase(out, a.in[26], gw, NGW, lane);
    STAMP();
#ifdef PROBE_A
    if (bx == 0 && tid == 0) { asm volatile("s_waitcnt vmcnt(0)" ::: "memory"); out[0] += (float)(stamps[PROBE_B] - stamps[PROBE_A]) * 1e-4f; }
#endif
}

#undef ws
#undef mod
#undef rope
#undef WGU1
#undef WD1
#undef WIN
#undef WOUT
#undef WGU2
#undef WD2
#undef H
#undef ACT
#undef QB
#undef KB
#undef VB
#undef OB
#undef out
extern "C" void kernel_launch(void* const* d_in, const int* in_sizes, int n_in, void* d_out, int out_size, void* d_ws, size_t ws_size, hipStream_t stream) {
    static int grid = 0;
    if (grid == 0) {
        if (n_in != 27 || ws_size < WS_END) { fprintf(stderr, "kernel_launch: unexpected n_in %d / ws %zu\n", n_in, ws_size); grid = -1; return; }
        int dev = 0, cus = 0, per_cu = 0;
        (void)hipGetDevice(&dev);
        (void)hipDeviceGetAttribute(&cus, hipDeviceAttributeMultiprocessorCount, dev);
        (void)hipFuncSetAttribute((const void*)fwd_megakernel, hipFuncAttributeMaxDynamicSharedMemorySize, LDS_BYTES);
        (void)hipOccupancyMaxActiveBlocksPerMultiprocessor(&per_cu, (const void*)fwd_megakernel, NWAVES * 64, LDS_BYTES);
        if (per_cu < 1) { fprintf(stderr, "kernel_launch: occupancy query says %d blocks/CU\n", per_cu); per_cu = 1; }
        grid = cus * per_cu;
    }
    if (grid < 0) return;
    (void)hipMemsetAsync((char*)d_ws + WS_MOD, 0, WS_CTL_BYTES, stream);
    Args a{};
    for (int i = 0; i < 27; ++i) a.in[i] = (const float*)d_in[i];
    a.o_ = (float*)d_out; a.w_ = (unsigned char*)d_ws;
    void* args[] = {&a};
    hipError_t e = hipLaunchCooperativeKernel((const void*)fwd_megakernel, dim3(grid), dim3(NWAVES * 64), args, LDS_BYTES, stream);
    if (e != hipSuccess) fprintf(stderr, "cooperative launch failed: %s (grid %d)\n", hipGetErrorString(e), grid);
}
```

```cpp
#include <hip/hip_runtime.h>
#include <hip/hip_cooperative_groups.h>
#include <hip/hip_bf16.h>
#include <cstdio>
#include <cstdint>
#include <cmath>
namespace cg = cooperative_groups;
namespace pg8 {
#define PG8_LAS __attribute__((address_space(3)))
typedef unsigned short bf16_t;
typedef short bf16x8 __attribute__((ext_vector_type(8)));
typedef float f32x4 __attribute__((ext_vector_type(4)));
typedef unsigned u32x4 __attribute__((ext_vector_type(4)));
constexpr int BM = 256, BK = 64, HALF = 128, HTB = HALF * BK * 2  , STAGE_BYTES = 8 * HTB, NXCD = 8, WGM = 8;

__host__ __device__ __forceinline__ int lds_byte(int r, int c) { const int st = (r >> 4) * 2 + (c >> 5), rr = r & 15, cc = c & 31, ob = rr * 64 + cc * 2; return st * 1024 + (ob ^ (((ob >> 9) & 1) << 5)); }
__host__ __device__ __forceinline__ void stage_rc(int b, int& R, int& C) { const int st = b / 1024, sb = b % 1024, swz = sb ^ (((sb >> 9) & 1) << 5); R = (st >> 1) * 16 + swz / 64; C = (st & 1) * 32 + (swz % 64) / 2; }
__host__ __device__ __forceinline__ int perm32(int rho) { const int n = rho >> 4, i = rho & 15; return 8 * (i >> 2) + 4 * n + (i & 3); }

struct Unit { int pm, pn, half; };
struct Gemm { const bf16_t* A; const bf16_t* Bt; int M, N, K; };

struct StaticOrder {
    int nM, nN, nwg, G, c, nfull, ntot;
    __host__ __device__ void init(int M, int N, int G_, int c_, bool split = true) { nM = M / BM; nN = N / BM; nwg = nM * nN; G = G_; c = c_;
        const int R = nwg % G; const bool sp = split && R > 0 && 2 * R <= G; nfull = sp ? nwg - R : nwg; ntot = nfull + 2 * (nwg - nfull); }
    __host__ __device__ bool next(int i, Unit& u) const {
        const long L = (long)i * G + c; if (L >= ntot) return false;
        int wgid; if (L < nfull) { wgid = (int)L; u.half = -1; } else { wgid = nfull + (int)(L - nfull) / 2; u.half = (int)(L - nfull) & 1; }
        { const int q = nwg / NXCD, r = nwg % NXCD, xcd = wgid % NXCD, off = wgid / NXCD; wgid = (xcd < r ? xcd * (q + 1) : r * (q + 1) + (xcd - r) * q) + off; }
        const int nig = WGM * nN, gid = wgid / nig, fm = gid * WGM, gsz = (nM - fm) < WGM ? (nM - fm) : WGM;
        u.pm = fm + ((wgid % nig) % gsz); u.pn = (wgid % nig) / gsz; return true;
    }
    __device__ __forceinline__ void a_ready(const Unit&) const {}
    __device__ __forceinline__ void done(const Unit&) const {}
};

__device__ __forceinline__ unsigned cvt_pk_bf16(float lo, float hi) { unsigned r; asm volatile("v_cvt_pk_bf16_f32 %0, %1, %2" : "=v"(r) : "v"(lo), "v"(hi)); return r; }
typedef float f32x2 __attribute__((ext_vector_type(2)));
typedef unsigned u32x2 __attribute__((ext_vector_type(2)));
constexpr float ATT_C2 = 0.125f * 1.4426950408889634f;
constexpr int NTOK = 24576, NCTX = 8192, DMODEL = 1024, DFF = 2816, NMODV = 9216;
constexpr int OFF_DK = 25165824, OFF_DV = 29360128, OFF_GK = 33554432, OFF_GV = 34603008;
__device__ __forceinline__ float silu_f(float g) { return g * __builtin_amdgcn_rcpf(1.0f + __builtin_amdgcn_exp2f(-1.4426950408889634f * g)); }
struct EpiSwiglu {
    static constexpr bool PERM = true, AFTER_DRAIN = false;
    bf16_t* O;
    __device__ __forceinline__ void operator()(const f32x4 (&acc)[2][2][4][2], const Unit& u, int wr, int wc, int fr_, int fq_) const {
        int fr = fr_, fq = fq_; asm volatile("" : "+v"(fr), "+v"(fq));
        const int row0 = u.pm * BM + (u.half > 0 ? HALF : 0) + wr * 64 + fr, col0 = u.pn * 128 + wc * 32 + 8 * fq;
#pragma unroll
        for (int ai = 0; ai < 2; ++ai)
#pragma unroll
            for (int m = 0; m < 4; ++m) {
                if (ai == 1 && u.half >= 0) continue;
                bf16_t* rowp = O + (size_t)(row0 + ai * HALF + m * 16) * DFF + col0;
                const f32x4 g0 = acc[ai][0][m][0], g1 = acc[ai][0][m][1], u0 = acc[ai][1][m][0], u1 = acc[ai][1][m][1];
                u32x4 w;
                w.x = cvt_pk_bf16(silu_f(g0[0]) * u0[0], silu_f(g0[1]) * u0[1]); w.y = cvt_pk_bf16(silu_f(g0[2]) * u0[2], silu_f(g0[3]) * u0[3]);
                w.z = cvt_pk_bf16(silu_f(g1[0]) * u1[0], silu_f(g1[1]) * u1[1]); w.w = cvt_pk_bf16(silu_f(g1[2]) * u1[2], silu_f(g1[3]) * u1[3]);
                *(u32x4*)rowp = w;
            }
    }
};
template <bool NTL> struct EpiResidT {
    static constexpr bool PERM = false, AFTER_DRAIN = false;
    const float* base; const float* base2; float* out; const float* mod; int gate_idx; float coef;
    __device__ __forceinline__ void operator()(const f32x4 (&acc)[2][2][4][2], const Unit& u, int wr, int wc, int fr_, int fq_) const {
        int fr = fr_, fq = fq_; asm volatile("" : "+v"(fr), "+v"(fq));
        const int mv = (u.pm < 32) ? 4 : ((u.pm - 32) >> 4);
        const float* gate = mod + mv * NMODV + gate_idx * DMODEL; const float* bs = (u.pm < 32) ? base : base2;
        const int row0 = u.pm * BM + (u.half > 0 ? HALF : 0) + wr * 64 + fr, col0 = u.pn * BM + wc * 32 + 4 * fq;
        f32x4 gv[2][2];
#pragma unroll
        for (int bj = 0; bj < 2; ++bj)
#pragma unroll
            for (int n = 0; n < 2; ++n) gv[bj][n] = *(const f32x4*)(gate + col0 + bj * HALF + n * 16) * coef;
#pragma unroll
        for (int ai = 0; ai < 2; ++ai)
#pragma unroll
            for (int m = 0; m < 4; ++m) {
                if (ai == 1 && u.half >= 0) continue;
                const size_t off = (size_t)(row0 + ai * HALF + m * 16) * DMODEL + col0;
#pragma unroll
                for (int bj = 0; bj < 2; ++bj)
#pragma unroll
                    for (int n = 0; n < 2; ++n) { const f32x4* bp = (const f32x4*)(bs + off + bj * HALF + n * 16); const f32x4 b = NTL ? __builtin_nontemporal_load(bp) : *bp; *(f32x4*)(out + off + bj * HALF + n * 16) = b + gv[bj][n] * acc[ai][bj][m][n]; }
                if (m & 1) asm volatile("" ::: "memory");
            }
    }
};
struct EpiQKV {
    static constexpr bool PERM = false, AFTER_DRAIN = false;
    bf16_t *QB, *KB, *VB; float* out; const float* qn; const float* kn; const float* rope;
    __device__ __forceinline__ void operator()(const f32x4 (&acc)[2][2][4][2], const Unit& u, int wr, int wc, int fr_, int fq_) const {
        int fr = fr_, fq = fq_; asm volatile("" : "+v"(fr), "+v"(fq));
        const int ch = u.pn * 4 + wc; const bool ctx = u.pm < 32;
        int kind, cc;
        if (ch < 8) { kind = 0; cc = ch; } else if (ch < 16) { kind = 1; cc = ch - 8; } else if (ch < 24) { kind = 2; cc = ch - 16; } else if (ch < 32) { kind = 3; cc = ch - 24; } else if (ch < 34) { kind = 4; cc = ch - 32; } else { kind = 5; cc = ch - 34; }
        const bool do_norm = (kind == 3 || kind == 4), do_rope = !ctx && (kind == 0 || kind == 1 || kind == 3 || kind == 4);
        const float qscale = (kind == 0 || kind == 3) ? ATT_C2 : 1.0f;
        bf16_t* dst; int dpitch, dcol; float* fo = nullptr; int fpitch = 0, fcol = 0;
        if (kind == 0) { dst = QB; dpitch = 1024; dcol = 64 * cc; }
        else if (kind == 3) { dst = QB; dpitch = 1024; dcol = 512 + 64 * cc; }
        else if (kind == 1) { dst = KB; dpitch = 640; dcol = 64 * cc; fo = out + OFF_DK; fpitch = 512; fcol = 64 * cc; }
        else if (kind == 4) { dst = KB; dpitch = 640; dcol = 512 + 64 * cc; fo = out + OFF_GK; fpitch = 128; fcol = 64 * cc; }
        else if (kind == 2) { dst = VB; dpitch = 640; dcol = 64 * cc; fo = out + OFF_DV; fpitch = 512; fcol = 64 * cc; }
        else { dst = VB; dpitch = 640; dcol = 512 + 64 * cc; fo = out + OFF_GV; fpitch = 128; fcol = 64 * cc; }
        const bool isq = (kind == 0 || kind == 3);
        const float* gnorm = (kind == 3 ? qn : kn) + 4 * fq;
#pragma unroll
        for (int ai = 0; ai < 2; ++ai)
#pragma unroll
            for (int m = 0; m < 4; ++m) {
                if (ai == 1 && u.half >= 0) continue;
                const int row = u.pm * BM + (u.half > 0 ? HALF : 0) + ai * HALF + wr * 64 + m * 16 + fr;
                f32x4 v[2][2];
#pragma unroll
                for (int bj = 0; bj < 2; ++bj)
#pragma unroll
                    for (int n = 0; n < 2; ++n) v[bj][n] = acc[ai][bj][m][n];
                if (do_norm) {
                    float ss = 0.f;
#pragma unroll
                    for (int bj = 0; bj < 2; ++bj)
#pragma unroll
                        for (int n = 0; n < 2; ++n) { const f32x4 x = v[bj][n]; ss += (x[0] * x[0] + x[1] * x[1]) + (x[2] * x[2] + x[3] * x[3]); }
                    ss += __shfl_xor(ss, 16); ss += __shfl_xor(ss, 32);
                    const float r = 1.0f / sqrtf(ss * (1.0f / 64.0f) + 1e-6f);
#pragma unroll
                    for (int bj = 0; bj < 2; ++bj)
#pragma unroll
                        for (int n = 0; n < 2; ++n) v[bj][n] = v[bj][n] * r * *(const f32x4*)(gnorm + 32 * bj + 16 * n);
                }
                int drow = row;
                if (ctx) {
                    if (fo) {
#pragma unroll
                        for (int bj = 0; bj < 2; ++bj)
#pragma unroll
                            for (int n = 0; n < 2; ++n) __builtin_nontemporal_store(v[bj][n], (f32x4*)(fo + (size_t)row * fpitch + fcol + 32 * bj + 16 * n + 4 * fq));
                    }
                } else {
                    const int tl = (row - NCTX) & 4095, lb = (row - NCTX) >> 12;
                    if (!isq) drow = NCTX + lb * 4608 + 512 + tl;
                    if (do_rope) {
#pragma unroll
                        for (int bj = 0; bj < 2; ++bj) {
                            const int pos = bj == 0 ? (tl >> 6) : (tl & 63);
                            const f32x4 c4 = *(const f32x4*)(rope + pos * 16 + 4 * fq), s4 = *(const f32x4*)(rope + 1024 + pos * 16 + 4 * fq);
                            const f32x4 x1 = v[bj][0], x2 = v[bj][1];
                            v[bj][0] = x1 * c4 - x2 * s4; v[bj][1] = x1 * s4 + x2 * c4;
                        }
                    }
                }
                bf16_t* dp = dst + (size_t)drow * dpitch + dcol + ((fq & 1) ? 16 + 4 * (fq - 1) : 4 * fq);
#pragma unroll
                for (int bj = 0; bj < 2; ++bj) { const f32x4 xa = v[bj][0] * qscale, xb = v[bj][1] * qscale;
                    unsigned a0 = cvt_pk_bf16(xa[0], xa[1]), a1 = cvt_pk_bf16(xa[2], xa[3]), b0 = cvt_pk_bf16(xb[0], xb[1]), b1 = cvt_pk_bf16(xb[2], xb[3]);
                    { auto r = __builtin_amdgcn_permlane16_swap(a0, b0, false, false); a0 = r[0]; b0 = r[1]; }
                    { auto r = __builtin_amdgcn_permlane16_swap(a1, b1, false, false); a1 = r[0]; b1 = r[1]; }
                    u32x4 w; w.x = a0; w.y = a1; w.z = b0; w.w = b1; *(u32x4*)(dp + 32 * bj) = w; }
                if (m & 1) { asm volatile("" ::: "memory"); __builtin_amdgcn_sched_barrier(0); }
            }
    }
};
template <class Epi, class Sched, bool ALIGN_EPI = false, bool SP2 = false>
__device__ __forceinline__ void gemm_phase(PG8_LAS unsigned char* lds, const Gemm g, const Sched& S, const Epi& E) {
    int tid_ = threadIdx.x; asm volatile("" : "+v"(tid_));
    const int tid = tid_, wid = __builtin_amdgcn_readfirstlane(tid >> 6), lane = tid & 63, wr = wid >> 2, wc = wid & 3, fr = lane & 15, fq = lane >> 4;
    const int K = g.K, nt = K / BK;
    unsigned voffA[2], voffB[2];
#pragma unroll
    for (int i = 0; i < 2; ++i) { int R, C; stage_rc(tid * 16 + i * 8192, R, C); const int Rb = Epi::PERM ? ((R & ~31) + perm32(R & 31)) : R;
        voffA[i] = (unsigned)(R * K + C) * 2u; voffB[i] = (unsigned)(Rb * K + C) * 2u; }
    const size_t kstep = (size_t)(BK * 2);
    const size_t hstep = (size_t)HALF * K * 2;
    const size_t tstep = 2 * hstep;
    const unsigned ldsw = (unsigned)wid * 1024u;
    const int aoff = lds_byte(wr * 64 + fr, fq * 8), boff = lds_byte(wc * 32 + fr, fq * 8);
#define PG8_SA(b, h) (((b) * 2 + (h)) * HTB)
#define PG8_SB(b, h) ((4 + (b) * 2 + (h)) * HTB)
#define PG8_STAGE(bufoff, gbase, voff) do { _Pragma("unroll") for (int _i = 0; _i < 2; ++_i) \
        __builtin_amdgcn_global_load_lds((const unsigned*)((const char*)(gbase) + (voff)[_i]), (PG8_LAS unsigned*)(lds + (bufoff) + ldsw + _i * 8192), 16, 0, 0); } while (0)
#define PG8_LDA(dst, b, h) do { _Pragma("unroll") for (int m = 0; m < 4; ++m) _Pragma("unroll") for (int k = 0; k < 2; ++k) dst[m][k] = *(const PG8_LAS bf16x8*)(lds + PG8_SA(b, h) + aoff + m * 2048 + k * 1024); } while (0)
#define PG8_LDB(dst, b, h) do { _Pragma("unroll") for (int n = 0; n < 2; ++n) _Pragma("unroll") for (int k = 0; k < 2; ++k) dst[n][k] = *(const PG8_LAS bf16x8*)(lds + PG8_SB(b, h) + boff + n * 2048 + k * 1024); } while (0)
#define PG8_MMA(ai, bj, At, Bt) do { __builtin_amdgcn_s_setprio(1); _Pragma("unroll") for (int m = 0; m < 4; ++m) _Pragma("unroll") for (int n = 0; n < 2; ++n) _Pragma("unroll") for (int k = 0; k < 2; ++k) \
        acc[ai][bj][m][n] = __builtin_amdgcn_mfma_f32_16x16x32_bf16(Bt[n][k], At[m][k], acc[ai][bj][m][n], 0, 0, 0); __builtin_amdgcn_s_setprio(0); } while (0)
#define PG8_WAIT_V(n) asm volatile("s_waitcnt vmcnt(" #n ")" ::: "memory")
#define PG8_WAIT_L(n) asm volatile("s_waitcnt lgkmcnt(" #n ")" ::: "memory")
#define PG8_BAR __builtin_amdgcn_s_barrier()
#define PG8_SCHED __builtin_amdgcn_sched_barrier(0)
    Unit cur, nxt; int ui = 0;
    if (!S.next(0, cur)) return;
    f32x4 acc[2][2][4][2];
#pragma unroll
    for (int a = 0; a < 2; ++a)
#pragma unroll
        for (int b = 0; b < 2; ++b)
#pragma unroll
            for (int m = 0; m < 4; ++m)
#pragma unroll
                for (int n = 0; n < 2; ++n) acc[a][b][m][n] = (f32x4){0.f, 0.f, 0.f, 0.f};
    bf16x8 At[4][2], B0[2][2], B1[2][2];
    const char* cA = (const char*)g.A + (size_t)cur.pm * tstep + (cur.half > 0 ? hstep : 0); const char* cB = (const char*)g.Bt + (size_t)cur.pn * tstep;
    size_t hcur = cur.half < 0 ? hstep : 0, hnxt = 0;
    S.a_ready(cur);
    if constexpr (SP2) {
        PG8_STAGE(PG8_SB(0, 0), cB, voffB); PG8_STAGE(PG8_SB(0, 1), cB + hstep, voffB); PG8_STAGE(PG8_SA(0, 0), cA, voffA); PG8_STAGE(PG8_SA(0, 1), cA + hcur, voffA);
        if (wr == 1) PG8_BAR;
        PG8_WAIT_V(2); PG8_BAR;
        PG8_STAGE(PG8_SB(1, 0), cB + kstep, voffB); PG8_STAGE(PG8_SA(1, 0), cA + kstep, voffA); PG8_STAGE(PG8_SB(1, 1), cB + hstep + kstep, voffB);
        PG8_WAIT_V(6); PG8_BAR;
    } else {
        PG8_STAGE(PG8_SB(0, 0), cB, voffB); PG8_STAGE(PG8_SA(0, 0), cA, voffA); PG8_STAGE(PG8_SB(0, 1), cB + hstep, voffB); PG8_STAGE(PG8_SA(0, 1), cA + hstep, voffA);
        if (wr == 1) PG8_BAR;
        PG8_WAIT_V(4); PG8_BAR;
        PG8_STAGE(PG8_SB(1, 0), cB + kstep, voffB); PG8_STAGE(PG8_SA(1, 0), cA + kstep, voffA); PG8_STAGE(PG8_SB(1, 1), cB + hstep + kstep, voffB);
        PG8_WAIT_V(6); PG8_BAR;
    }
    for (;;) {
        const bool has_next = S.next(ui + 1, nxt);
        const char* nA = has_next ? (const char*)g.A + (size_t)nxt.pm * tstep + (nxt.half > 0 ? hstep : 0) : cA; const char* nB = has_next ? (const char*)g.Bt + (size_t)nxt.pn * tstep : cB;
        hnxt = has_next ? (nxt.half < 0 ? hstep : 0) : hcur; const bool fullu = cur.half < 0;
        for (int t = 0; t < nt; t += 2) {
            const bool last = (t == nt - 2);
            const char* a1 = cA + (size_t)(t + 1) * kstep;
            const char* a2 = last ? nA : cA + (size_t)(t + 2) * kstep; const char* b2 = last ? nB : cB + (size_t)(t + 2) * kstep;
            const char* a3 = a2 + kstep; const char* b3 = b2 + kstep;
            if (last && has_next) S.a_ready(nxt);
            if constexpr (SP2) {
            PG8_LDB(B0, 0, 0); PG8_LDB(B1, 0, 1); PG8_SCHED; PG8_LDA(At, 0, 0); PG8_STAGE(PG8_SA(1, 1), a1 + hcur, voffA);
            PG8_WAIT_V(8); PG8_WAIT_L(0); PG8_BAR; PG8_MMA(0, 0, At, B0); PG8_MMA(0, 1, At, B1); PG8_BAR; PG8_SCHED;
            if (fullu) PG8_LDA(At, 0, 1); PG8_STAGE(PG8_SB(0, 0), b2, voffB); PG8_STAGE(PG8_SB(0, 1), b2 + hstep, voffB); PG8_STAGE(PG8_SA(0, 0), a2, voffA);
            PG8_WAIT_V(8); PG8_WAIT_L(0); PG8_BAR; if (fullu) { PG8_MMA(1, 0, At, B0); PG8_MMA(1, 1, At, B1); } PG8_BAR; PG8_SCHED;
            PG8_LDB(B0, 1, 0); PG8_LDB(B1, 1, 1); PG8_SCHED; PG8_LDA(At, 1, 0); PG8_STAGE(PG8_SA(0, 1), a2 + (last ? hnxt : hcur), voffA);
            PG8_WAIT_V(8); PG8_WAIT_L(0); PG8_BAR; PG8_MMA(0, 0, At, B0); PG8_MMA(0, 1, At, B1); PG8_BAR; PG8_SCHED;
            if (fullu) PG8_LDA(At, 1, 1); PG8_STAGE(PG8_SB(1, 0), b3, voffB); PG8_STAGE(PG8_SB(1, 1), b3 + hstep, voffB); PG8_STAGE(PG8_SA(1, 0), a3, voffA);
            PG8_WAIT_V(8); PG8_WAIT_L(0); PG8_BAR; if (fullu) { PG8_MMA(1, 0, At, B0); PG8_MMA(1, 1, At, B1); } PG8_BAR; PG8_SCHED;
            } else {
            PG8_LDB(B0, 0, 0); PG8_SCHED; PG8_LDA(At, 0, 0); PG8_STAGE(PG8_SA(1, 1), a1 + hstep, voffA);
            PG8_WAIT_L(8); PG8_BAR; PG8_WAIT_L(0); PG8_MMA(0, 0, At, B0); PG8_BAR; PG8_SCHED;
            PG8_LDB(B1, 0, 1); PG8_STAGE(PG8_SB(0, 0), b2, voffB);
            PG8_BAR; PG8_WAIT_L(0); PG8_MMA(0, 1, At, B1); PG8_BAR;
            PG8_LDA(At, 0, 1); PG8_STAGE(PG8_SA(0, 0), a2, voffA);
            PG8_BAR; PG8_WAIT_L(0); PG8_MMA(1, 0, At, B0); PG8_BAR; PG8_SCHED;
            PG8_STAGE(PG8_SB(0, 1), b2 + hstep, voffB);
            PG8_WAIT_V(6); PG8_BAR; PG8_MMA(1, 1, At, B1); PG8_BAR;
            PG8_LDB(B0, 1, 0); PG8_SCHED; PG8_LDA(At, 1, 0); PG8_STAGE(PG8_SA(0, 1), a2 + hstep, voffA);
            PG8_WAIT_L(8); PG8_BAR; PG8_WAIT_L(0); PG8_MMA(0, 0, At, B0); PG8_BAR; PG8_SCHED;
            PG8_LDB(B1, 1, 1); PG8_STAGE(PG8_SB(1, 0), b3, voffB);
            PG8_BAR; PG8_WAIT_L(0); PG8_MMA(0, 1, At, B1); PG8_BAR;
            PG8_LDA(At, 1, 1); PG8_STAGE(PG8_SA(1, 0), a3, voffA);
            PG8_BAR; PG8_WAIT_L(0); PG8_MMA(1, 0, At, B0); PG8_BAR; PG8_SCHED;
            PG8_STAGE(PG8_SB(1, 1), b3 + hstep, voffB);
            PG8_WAIT_V(6); PG8_BAR; PG8_MMA(1, 1, At, B1); PG8_BAR;
            }
        }
        if constexpr (ALIGN_EPI) { if (wr == 0) PG8_BAR; }
        if constexpr (!Epi::AFTER_DRAIN) { E(acc, cur, wr, wc, fr, fq); S.done(cur); }
        if (!has_next) break;
#pragma unroll
        for (int a = 0; a < 2; ++a)
#pragma unroll
            for (int b = 0; b < 2; ++b)
#pragma unroll
                for (int m = 0; m < 4; ++m)
#pragma unroll
                    for (int n = 0; n < 2; ++n) acc[a][b][m][n] = (f32x4){0.f, 0.f, 0.f, 0.f};
        cur = nxt; cA = nA; cB = nB; hcur = hnxt; ++ui;
        if constexpr (ALIGN_EPI) { if (wr == 1) PG8_BAR; }
    }
    PG8_WAIT_V(0);
    if constexpr (!ALIGN_EPI) { if (wr == 0) PG8_BAR; }
    PG8_BAR;
    if constexpr (Epi::AFTER_DRAIN) { E.fused(acc, cur, wr, wc, fr, fq, lds, wid, lane); S.done(cur); }
#undef PG8_SA
#undef PG8_SB
#undef PG8_STAGE
#undef PG8_LDA
#undef PG8_LDB
#undef PG8_MMA
#undef PG8_WAIT_V
#undef PG8_WAIT_L
#undef PG8_BAR
#undef PG8_SCHED
}
}

#ifndef PG8_SP2
#define PG8_SP2 true
#endif
#ifndef PG8_ALIGN
#define PG8_ALIGN true
#endif
namespace attn_body {
using bf16=__hip_bfloat16;
using bf16x8=__attribute__((ext_vector_type(8)))short;
using s16x4=__attribute__((ext_vector_type(4)))short;
using f32x16=__attribute__((ext_vector_type(16)))float;
using u32x4=__attribute__((ext_vector_type(4)))unsigned;
constexpr int D=64;
constexpr int NW=8,QBLK=32,QB=QBLK*NW,KVBLK=64;
__device__ __forceinline__ int crow(int r,int hi){return (r&3)+8*(r>>2)+4*hi;}
#define SBAR() __builtin_amdgcn_sched_barrier(0)
__device__ __forceinline__ void cmask(f32x16&p0,f32x16&p1,int jb,int qrel,int hi){
  const float NEG=-INFINITY; int kb=64*jb+4*hi;
  #pragma unroll
  for(int r=0;r<16;++r){int kv=kb+(r&3)+8*(r>>2); if(kv>qrel)p0[r]=NEG; if(kv+32>qrel)p1[r]=NEG;}
}

constexpr int NSLOT=3, SLOTB=8192;
constexpr int LDS_K=0, LDS_V=NSLOT*SLOTB, LDS_WS=LDS_V+NSLOT*2*SLOTB, LDS_OST=LDS_WS+NW*64*4, LDS_BYTES=LDS_OST+NW*8192;
constexpr float C2=0.125f*1.4426950408889634f;
__device__ __forceinline__ void glds16(const void*gsrc,unsigned lds_dst){unsigned keep;
  asm volatile("s_mov_b32 %0, m0\n\ts_mov_b32 m0, %2\n\ts_nop 0\n\tglobal_load_lds_dwordx4 %1, off\n\ts_mov_b32 m0, %0":"=&s"(keep):"v"(gsrc),"s"(lds_dst):"memory");}
__device__ __forceinline__ float max3f(float a,float b,float c){float r;asm("v_max3_f32 %0, %1, %2, %3":"=v"(r):"v"(a),"v"(b),"v"(c));return r;}
__device__ __forceinline__ float max2f(float a,float b){float r;asm("v_max_f32_e32 %0, %1, %2":"=v"(r):"v"(a),"v"(b));return r;}
__device__ __forceinline__ float fadd_s(float a,float b){float r;asm("v_add_f32_e32 %0, %1, %2":"=v"(r):"v"(a),"v"(b));return r;}
__device__ __forceinline__ float fsub_s(float a,float b){float r;asm("v_sub_f32_e32 %0, %1, %2":"=v"(r):"v"(a),"v"(b));return r;}
typedef float f32x2_t __attribute__((ext_vector_type(2))); typedef __bf16 bf16x2_t __attribute__((ext_vector_type(2)));
__device__ __forceinline__ unsigned cvtpk_s(float lo,float hi){f32x2_t v={lo,hi};bf16x2_t b=__builtin_convertvector(v,bf16x2_t);return __builtin_bit_cast(unsigned,b);}
#define WAIT_BAR(N) asm volatile("s_waitcnt vmcnt(" #N ") lgkmcnt(0)\n\ts_barrier":::"memory")

__device__ __forceinline__ void qkt(f32x16&p0,f32x16&p1,const char*Kslot,const bf16x8*qr,const f32x16&negm,int r32,int hi){
  const char*kb=Kslot+hi*1024+r32*16;
  #pragma unroll
  for(int d0=0;d0<4;++d0){
    const bf16x8 b0=*reinterpret_cast<const bf16x8*>(kb+d0*2048);
    const bf16x8 b1=*reinterpret_cast<const bf16x8*>(kb+d0*2048+512);
    if(d0==0){p0=__builtin_amdgcn_mfma_f32_32x32x16_bf16(b0,qr[0],negm,0,0,0);p1=__builtin_amdgcn_mfma_f32_32x32x16_bf16(b1,qr[0],negm,0,0,0);}
    else{p0=__builtin_amdgcn_mfma_f32_32x32x16_bf16(b0,qr[d0],p0,0,0,0);p1=__builtin_amdgcn_mfma_f32_32x32x16_bf16(b1,qr[d0],p1,0,0,0);}}
}
typedef __attribute__((address_space(3))) const char* lds_cptr;
typedef short v4i16_t __attribute__((ext_vector_type(4)));
__device__ __forceinline__ void kload8(bf16x8*kf,lds_cptr kp){
  kf[0]=*(const __attribute__((address_space(3))) bf16x8*)(kp);      kf[1]=*(const __attribute__((address_space(3))) bf16x8*)(kp+512);
  kf[2]=*(const __attribute__((address_space(3))) bf16x8*)(kp+2048); kf[3]=*(const __attribute__((address_space(3))) bf16x8*)(kp+2560);
  kf[4]=*(const __attribute__((address_space(3))) bf16x8*)(kp+4096); kf[5]=*(const __attribute__((address_space(3))) bf16x8*)(kp+4608);
  kf[6]=*(const __attribute__((address_space(3))) bf16x8*)(kp+6144); kf[7]=*(const __attribute__((address_space(3))) bf16x8*)(kp+6656);
}
__device__ __forceinline__ void kload2(bf16x8*kf,lds_cptr kp,int j){ kf[2*j]=*(const __attribute__((address_space(3))) bf16x8*)(kp+j*2048); kf[2*j+1]=*(const __attribute__((address_space(3))) bf16x8*)(kp+j*2048+512); }
__device__ __forceinline__ s16x4 vtr(lds_cptr p){ return __builtin_bit_cast(s16x4,__builtin_amdgcn_ds_read_tr16_b64_v4i16((__attribute__((address_space(3))) v4i16_t*)p)); }
__device__ __forceinline__ float rowmax(const f32x16&p0,const f32x16&p1){
  float a=max3f(p0[0],p0[1],p1[0]),b=max3f(p0[2],p0[3],p1[1]);a=max3f(a,p1[2],p1[3]);
  #pragma unroll
  for(int r=4;r<16;r+=4){a=max3f(a,p0[r],p0[r+1]);b=max3f(b,p0[r+2],p0[r+3]);a=max3f(a,p1[r],p1[r+1]);b=max3f(b,p1[r+2],p1[r+3]);}
  const float m=max2f(a,b);
  auto rr=__builtin_amdgcn_permlane32_swap(__float_as_uint(m),__float_as_uint(m),false,false);
  return max2f(__uint_as_float(rr[0]),__uint_as_float(rr[1]));
}
template<int NVQ> __device__ __forceinline__ void pv(f32x16*o,int vb,bf16x8 pa0,bf16x8 pa1,bf16x8 pa2,bf16x8 pa3){
  #pragma unroll
  for(int d0=0;d0<NVQ;++d0){s16x4 lo[4],hi[4];
    #pragma unroll
    for(int ks=0;ks<4;++ks){
      asm volatile("ds_read_b64_tr_b16 %0,%1 offset:%c2":"=&v"(lo[ks]):"v"(vb),"i"(d0*4096+ks*1024):"memory");
      asm volatile("ds_read_b64_tr_b16 %0,%1 offset:%c2":"=&v"(hi[ks]):"v"(vb),"i"(d0*4096+ks*1024+512):"memory");}
    asm volatile("s_waitcnt lgkmcnt(0)":::"memory");SBAR();
    #define PK(k) (bf16x8){lo[k][0],lo[k][1],lo[k][2],lo[k][3],hi[k][0],hi[k][1],hi[k][2],hi[k][3]}
    o[d0]=__builtin_amdgcn_mfma_f32_32x32x16_bf16(pa0,PK(0),o[d0],0,0,0);
    o[d0]=__builtin_amdgcn_mfma_f32_32x32x16_bf16(pa1,PK(1),o[d0],0,0,0);
    o[d0]=__builtin_amdgcn_mfma_f32_32x32x16_bf16(pa2,PK(2),o[d0],0,0,0);
    o[d0]=__builtin_amdgcn_mfma_f32_32x32x16_bf16(pa3,PK(3),o[d0],0,0,0);
    #undef PK
  }
}

#ifndef ATTN_STORE16
#define ATTN_STORE16(p,v) (*(u32x4*)(p)=(v))
#endif
template<int THRL,int QP,int KP,int NVQ> __device__ __forceinline__ void attn_pass(const bf16*Qblk,const bf16*__restrict__ Kh,const bf16*__restrict__ Vh,int NT,bf16*Odst,int ecol,float lam,int MODE,char*shm){
  int tid_=threadIdx.x; asm volatile("":"+v"(tid_)); const int tid=tid_,lane=tid&63,r32=lane&31,hi=lane>>5; const int wid=__builtin_amdgcn_readfirstlane(tid>>6);
  const bf16*Qw=Qblk+(long)(wid*QBLK)*QP;
  const unsigned lds0=(unsigned)(uintptr_t)shm;
  float*wsf=(float*)(shm+LDS_WS)+wid*64;
  const bf16*ksrc=Kh+(long)lane*KP+wid*8;
  const bf16*vsrc=Vh+(long)(16*(wid&3)+(lane>>2))*KP+(wid>>2)*32+(lane&3)*8;
  const unsigned kdst=lds0+LDS_K+wid*1024, vdst=lds0+LDS_V+wid*1024;
  #define DMA_K(t,slot) glds16(ksrc+(long)(t)*KVBLK*KP,(unsigned)__builtin_amdgcn_readfirstlane(kdst+(slot)))
  #define DMA_V(t,slot) do{ glds16(vsrc+(long)(t)*KVBLK*KP,(unsigned)__builtin_amdgcn_readfirstlane(vdst+2*(slot))); if constexpr(NVQ==4) glds16(vsrc+(long)(t)*KVBLK*KP+64,(unsigned)__builtin_amdgcn_readfirstlane(vdst+2*(slot)+8192)); }while(0)
  #define WAITB(n2,n4) do{ if constexpr(NVQ==4){WAIT_BAR(n4);} else {WAIT_BAR(n2);} }while(0)
  const int vb0=(int)(lds0+LDS_V)+((lane>>4)&1)*32+(lane&3)*8+(4*hi+((lane&15)>>2))*64;
  const char*Kbase=shm+LDS_K; bf16x8 kf[8];
  const lds_cptr shm3=(lds_cptr)shm; const lds_cptr kp0=shm3+LDS_K+hi*1024+r32*16; const lds_cptr vp0=shm3+LDS_V+((lane>>4)&1)*32+(lane&3)*8+(4*hi+((lane&15)>>2))*64;
  if(wid>=4)__builtin_amdgcn_s_setprio(1);
  DMA_K(0,0);DMA_V(0,0);DMA_K(1,SLOTB);
  bf16x8 qr[4];
  #pragma unroll
  for(int d0=0;d0<4;++d0)qr[d0]=*reinterpret_cast<const bf16x8*>(&Qw[(long)r32*QP+d0*16+hi*8]);
  float mhat=0.f,l_reg=0.f;f32x16 o[NVQ];
  #pragma unroll
  for(int d_=0;d_<NVQ;++d_)o[d_]=f32x16{};
  f32x16 negm=f32x16{};asm volatile("":"+v"(negm));
  #define CMASK(P0,P1,t) do{}while(0)
  bool resc=false;
  #define START(P0,P1) do{ const float rm=rowmax(P0,P1); resc=false; \
    { const float dl=rm; mhat=fadd_s(mhat,dl); \
      _Pragma("unroll") for(int r=0;r<16;++r){P0[r]=fsub_s(P0[r],dl);P1[r]=fsub_s(P1[r],dl);} \
      _Pragma("unroll") for(int r=0;r<16;++r)negm[r]=-mhat; asm volatile("":"+v"(negm)); } \
    _Pragma("unroll") for(int r=0;r<16;++r)P0[r]=__builtin_amdgcn_exp2f(P0[r]); }while(0)
  #define RESC() do{ if(resc){ asm volatile("s_waitcnt lgkmcnt(0)":::"memory"); \
      _Pragma("unroll") for(int d_=0;d_<NVQ;++d_) _Pragma("unroll") for(int r=0;r<16;++r)o[d_][r]*=wsf[crow(r,hi)]; } }while(0)
  f32x16 pA0,pA1,pB0,pB1;
  int sl_prev=0,sl_cur=0,sl_next=SLOTB;
  #define ROT() do{sl_prev=sl_cur;sl_cur=sl_next;sl_next=(sl_next==(NSLOT-1)*SLOTB)?0:sl_next+SLOTB;}while(0)
  DMA_K(2,2*SLOTB);
  WAITB(3,4);
  qkt(pA0,pA1,Kbase,qr,negm,r32,hi);asm volatile("s_nop 15\n\ts_nop 7":"+v"(pA0),"+v"(pA1));CMASK(pA0,pA1,0);
  START(pA0,pA1);
  _Pragma("unroll") for(int r=0;r<16;++r)pA1[r]=__builtin_amdgcn_exp2f(pA1[r]);
  WAIT_BAR(0);
  DMA_K(3,0);DMA_V(1,SLOTB);
  ROT();
  kload8(kf,kp0+sl_cur);
  WAITB(2,3);
  s16x4 vlo[8],vhi[8]; u32x4 pw0,pw1,pw2,pw3;
  #define PKW(P,B) cvtpk_s(P[B],P[B+1])
  #define PAF(k) __builtin_bit_cast(bf16x8,pw##k)
  #define VFR(i) (bf16x8){vlo[i][0],vlo[i][1],vlo[i][2],vlo[i][3],vhi[i][0],vhi[i][1],vhi[i][2],vhi[i][3]}
  #define PIN(x) asm volatile("":"+v"(x))
  #define MX3(a,b,c) __builtin_fmaxf(__builtin_fmaxf((a),(b)),(c))
  #define GAPA(MF,A0,A1,A2,A3,W0,W1,PW) do{ MF; sacc+=A0; sacc+=A1; sacc+=A2; sacc+=A3; PIN(sacc); W0; W1; PIN(PW); SBAR(); }while(0)
  #define EX(v) __builtin_amdgcn_exp2f(v)
  #define GAPB(MF,X,B) do{ MF; X[B]=EX(X[B]); X[B+1]=EX(X[B+1]); X[B+2]=EX(X[B+2]); X[B+3]=EX(X[B+3]); PIN(X); SBAR(); }while(0)
  #define VRD(i) do{ vlo[i]=vtr(vp_+(((i)>>2)*4096+((i)&3)*1024)); vhi[i]=vtr(vp_+(((i)>>2)*4096+((i)&3)*1024+512)); }while(0)
  #define GAPB2(MF,X,B) do{ MF; X[B]=EX(X[B]); X[B+1]=EX(X[B+1]); PIN(X); SBAR(); }while(0)
  #define VRF(r,i) do{ vlo[r]=vtr(vp_+(((i)>>2)*4096+((i)&3)*1024)); vhi[r]=vtr(vp_+(((i)>>2)*4096+((i)&3)*1024+512)); }while(0)
  #define VRD2(i) do{ vlo[i]=vtr(vp_+(8192+((i)>>2)*4096+((i)&3)*1024)); vhi[i]=vtr(vp_+(8192+((i)>>2)*4096+((i)&3)*1024+512)); }while(0)
  #define KRD(G,j) do{ if(G){ kload2(kf,kp0+sl_next,j); SBAR(); } }while(0)
  #define STEP(C0,C1,P0,P1,t,GK,GV,GL) do{ SBAR(); \
    const lds_cptr vp_=vp0+2*sl_prev; \
    VRD(0); SBAR(); float sacc=(P0[0]+P0[1]); \
    GAPA(C0=__builtin_amdgcn_mfma_f32_32x32x16_bf16(kf[0],qr[0],negm,0,0,0), P0[2],P0[3],P0[4],P0[5],     pw0[0]=PKW(P0,0), pw0[1]=PKW(P0,2), pw0); \
    VRD(4); SBAR(); GAPA(C1=__builtin_amdgcn_mfma_f32_32x32x16_bf16(kf[1],qr[0],negm,0,0,0), P0[6],P0[7],P0[8],P0[9],     pw0[2]=PKW(P0,4), pw0[3]=PKW(P0,6), pw0); \
    VRD(1); SBAR(); GAPA(C0=__builtin_amdgcn_mfma_f32_32x32x16_bf16(kf[2],qr[1],C0,0,0,0),   P0[10],P0[11],P0[12],P0[13], pw1[0]=PKW(P0,8), pw1[1]=PKW(P0,10), pw1); \
    VRD(5); SBAR(); GAPA(C1=__builtin_amdgcn_mfma_f32_32x32x16_bf16(kf[3],qr[1],C1,0,0,0),   P0[14],P0[15],P1[0],P1[1],   pw1[2]=PKW(P0,12),pw1[3]=PKW(P0,14), pw1); \
    VRD(2); SBAR(); GAPA(C0=__builtin_amdgcn_mfma_f32_32x32x16_bf16(kf[4],qr[2],C0,0,0,0),   P1[2],P1[3],P1[4],P1[5],     pw2[0]=PKW(P1,0), pw2[1]=PKW(P1,2), pw2); \
    VRD(6); SBAR(); GAPA(C1=__builtin_amdgcn_mfma_f32_32x32x16_bf16(kf[5],qr[2],C1,0,0,0),   P1[6],P1[7],P1[8],P1[9],     pw2[2]=PKW(P1,4), pw2[3]=PKW(P1,6), pw2); \
    VRD(3); SBAR(); GAPA(C0=__builtin_amdgcn_mfma_f32_32x32x16_bf16(kf[6],qr[3],C0,0,0,0),   P1[10],P1[11],P1[12],P1[13], pw3[0]=PKW(P1,8), pw3[1]=PKW(P1,10), pw3); \
    VRD(7); SBAR(); GAPA(C1=__builtin_amdgcn_mfma_f32_32x32x16_bf16(kf[7],qr[3],C1,0,0,0),   P1[14],P1[15],0.f,0.f,       pw3[2]=PKW(P1,12),pw3[3]=PKW(P1,14), pw3); \
    l_reg+=sacc; \
    if(GK){DMA_K((t)+3,sl_cur);} if(GV){DMA_V((t)+1,sl_next);} \
    CMASK(C0,C1,t); \
    { float a=MX3(C0[0],C0[1],C1[0]),b=MX3(C0[2],C0[3],C1[1]); a=MX3(a,C1[2],C1[3]); \
      _Pragma("unroll") for(int r=4;r<16;r+=4){a=MX3(a,C0[r],C0[r+1]);b=MX3(b,C0[r+2],C0[r+3]);a=MX3(a,C1[r],C1[r+1]);b=MX3(b,C1[r+2],C1[r+3]);} \
      float rm=__builtin_fmaxf(a,b); { auto rr=__builtin_amdgcn_permlane32_swap(__float_as_uint(rm),__float_as_uint(rm),false,false); rm=__builtin_fmaxf(__uint_as_float(rr[0]),__uint_as_float(rr[1])); } \
      resc=false; \
      if(__builtin_expect(__any(rm>(float)THRL),0)){ const float dl=__builtin_fmaxf(rm,0.f); mhat+=dl; \
        _Pragma("unroll") for(int r=0;r<16;++r){C0[r]-=dl;C1[r]-=dl;} \
        _Pragma("unroll") for(int r=0;r<16;++r)negm[r]=-mhat; asm volatile("":"+v"(negm)); \
        const float f=__builtin_amdgcn_exp2f(-dl); l_reg*=f; if(hi==0)wsf[r32]=f; resc=true; } } \
    SBAR(); \
    GAPB(o[0]=__builtin_amdgcn_mfma_f32_32x32x16_bf16(PAF(0),VFR(0),o[0],0,0,0), C0,0); \
    GAPB(o[1]=__builtin_amdgcn_mfma_f32_32x32x16_bf16(PAF(0),VFR(4),o[1],0,0,0), C0,4); \
    KRD(GL,0); GAPB(o[0]=__builtin_amdgcn_mfma_f32_32x32x16_bf16(PAF(1),VFR(1),o[0],0,0,0), C0,8); \
    KRD(GL,1); GAPB(o[1]=__builtin_amdgcn_mfma_f32_32x32x16_bf16(PAF(1),VFR(5),o[1],0,0,0), C0,12); \
    KRD(GL,2); GAPB(o[0]=__builtin_amdgcn_mfma_f32_32x32x16_bf16(PAF(2),VFR(2),o[0],0,0,0), C1,0); \
    KRD(GL,3); GAPB(o[1]=__builtin_amdgcn_mfma_f32_32x32x16_bf16(PAF(2),VFR(6),o[1],0,0,0), C1,4); \
    GAPB(o[0]=__builtin_amdgcn_mfma_f32_32x32x16_bf16(PAF(3),VFR(3),o[0],0,0,0), C1,8); \
    GAPB(o[1]=__builtin_amdgcn_mfma_f32_32x32x16_bf16(PAF(3),VFR(7),o[1],0,0,0), C1,12); \
    }while(0)
  #define STEP4(C0,C1,P0,P1,t,GK,GV,GL) do{ SBAR(); \
    const lds_cptr vp_=vp0+2*sl_prev; \
    float sacc=(P0[0]+P0[1]); \
    GAPA(C0=__builtin_amdgcn_mfma_f32_32x32x16_bf16(kf[0],qr[0],negm,0,0,0), P0[2],P0[3],P0[4],P0[5],     pw0[0]=PKW(P0,0), pw0[1]=PKW(P0,2), pw0); \
    GAPA(C1=__builtin_amdgcn_mfma_f32_32x32x16_bf16(kf[1],qr[0],negm,0,0,0), P0[6],P0[7],P0[8],P0[9],     pw0[2]=PKW(P0,4), pw0[3]=PKW(P0,6), pw0); \
    GAPA(C0=__builtin_amdgcn_mfma_f32_32x32x16_bf16(kf[2],qr[1],C0,0,0,0),   P0[10],P0[11],P0[12],P0[13], pw1[0]=PKW(P0,8), pw1[1]=PKW(P0,10), pw1); \
    GAPA(C1=__builtin_amdgcn_mfma_f32_32x32x16_bf16(kf[3],qr[1],C1,0,0,0),   P0[14],P0[15],P1[0],P1[1],   pw1[2]=PKW(P0,12),pw1[3]=PKW(P0,14), pw1); \
    VRF(0,0); SBAR(); GAPA(C0=__builtin_amdgcn_mfma_f32_32x32x16_bf16(kf[4],qr[2],C0,0,0,0),   P1[2],P1[3],P1[4],P1[5],     pw2[0]=PKW(P1,0), pw2[1]=PKW(P1,2), pw2); \
    VRF(1,4); SBAR(); GAPA(C1=__builtin_amdgcn_mfma_f32_32x32x16_bf16(kf[5],qr[2],C1,0,0,0),   P1[6],P1[7],P1[8],P1[9],     pw2[2]=PKW(P1,4), pw2[3]=PKW(P1,6), pw2); \
    VRF(2,8); SBAR(); GAPA(C0=__builtin_amdgcn_mfma_f32_32x32x16_bf16(kf[6],qr[3],C0,0,0,0),   P1[10],P1[11],P1[12],P1[13], pw3[0]=PKW(P1,8), pw3[1]=PKW(P1,10), pw3); \
    VRF(3,12); SBAR(); GAPA(C1=__builtin_amdgcn_mfma_f32_32x32x16_bf16(kf[7],qr[3],C1,0,0,0),   P1[14],P1[15],0.f,0.f,       pw3[2]=PKW(P1,12),pw3[3]=PKW(P1,14), pw3); \
    l_reg+=sacc; \
    if(GK){DMA_K((t)+3,sl_cur);} if(GV){DMA_V((t)+1,sl_next);} \
    CMASK(C0,C1,t); \
    { float a=MX3(C0[0],C0[1],C1[0]),b=MX3(C0[2],C0[3],C1[1]); a=MX3(a,C1[2],C1[3]); \
      _Pragma("unroll") for(int r=4;r<16;r+=4){a=MX3(a,C0[r],C0[r+1]);b=MX3(b,C0[r+2],C0[r+3]);a=MX3(a,C1[r],C1[r+1]);b=MX3(b,C1[r+2],C1[r+3]);} \
      float rm=__builtin_fmaxf(a,b); { auto rr=__builtin_amdgcn_permlane32_swap(__float_as_uint(rm),__float_as_uint(rm),false,false); rm=__builtin_fmaxf(__uint_as_float(rr[0]),__uint_as_float(rr[1])); } \
      resc=false; \
      if(__builtin_expect(__any(rm>(float)THRL),0)){ const float dl=__builtin_fmaxf(rm,0.f); mhat+=dl; \
        _Pragma("unroll") for(int r=0;r<16;++r){C0[r]-=dl;C1[r]-=dl;} \
        _Pragma("unroll") for(int r=0;r<16;++r)negm[r]=-mhat; asm volatile("":"+v"(negm)); \
        const float f=__builtin_amdgcn_exp2f(-dl); l_reg*=f; if(hi==0)wsf[r32]=f; resc=true; } } \
    SBAR(); \
    GAPB2(o[0]=__builtin_amdgcn_mfma_f32_32x32x16_bf16(PAF(0),VFR(0),o[0],0,0,0), C0,0); VRF(0,1); SBAR(); \
    GAPB2(o[1]=__builtin_amdgcn_mfma_f32_32x32x16_bf16(PAF(0),VFR(1),o[1],0,0,0), C0,2); VRF(1,5); SBAR(); \
    GAPB2(o[2]=__builtin_amdgcn_mfma_f32_32x32x16_bf16(PAF(0),VFR(2),o[2],0,0,0), C0,4); VRF(2,9); SBAR(); \
    GAPB2(o[3]=__builtin_amdgcn_mfma_f32_32x32x16_bf16(PAF(0),VFR(3),o[3],0,0,0), C0,6); VRF(3,13); SBAR(); \
    GAPB2(o[0]=__builtin_amdgcn_mfma_f32_32x32x16_bf16(PAF(1),VFR(0),o[0],0,0,0), C0,8); VRF(0,2); SBAR(); \
    GAPB2(o[1]=__builtin_amdgcn_mfma_f32_32x32x16_bf16(PAF(1),VFR(1),o[1],0,0,0), C0,10); VRF(1,6); SBAR(); \
    GAPB2(o[2]=__builtin_amdgcn_mfma_f32_32x32x16_bf16(PAF(1),VFR(2),o[2],0,0,0), C0,12); VRF(2,10); SBAR(); \
    GAPB2(o[3]=__builtin_amdgcn_mfma_f32_32x32x16_bf16(PAF(1),VFR(3),o[3],0,0,0), C0,14); VRF(3,14); SBAR(); \
    KRD(GL,0); GAPB2(o[0]=__builtin_amdgcn_mfma_f32_32x32x16_bf16(PAF(2),VFR(0),o[0],0,0,0), C1,0); VRF(0,3); SBAR(); \
    GAPB2(o[1]=__builtin_amdgcn_mfma_f32_32x32x16_bf16(PAF(2),VFR(1),o[1],0,0,0), C1,2); VRF(1,7); SBAR(); \
    KRD(GL,1); GAPB2(o[2]=__builtin_amdgcn_mfma_f32_32x32x16_bf16(PAF(2),VFR(2),o[2],0,0,0), C1,4); VRF(2,11); SBAR(); \
    GAPB2(o[3]=__builtin_amdgcn_mfma_f32_32x32x16_bf16(PAF(2),VFR(3),o[3],0,0,0), C1,6); VRF(3,15); SBAR(); \
    KRD(GL,2); GAPB2(o[0]=__builtin_amdgcn_mfma_f32_32x32x16_bf16(PAF(3),VFR(0),o[0],0,0,0), C1,8); \
    GAPB2(o[1]=__builtin_amdgcn_mfma_f32_32x32x16_bf16(PAF(3),VFR(1),o[1],0,0,0), C1,10); \
    KRD(GL,3); GAPB2(o[2]=__builtin_amdgcn_mfma_f32_32x32x16_bf16(PAF(3),VFR(2),o[2],0,0,0), C1,12); \
    GAPB2(o[3]=__builtin_amdgcn_mfma_f32_32x32x16_bf16(PAF(3),VFR(3),o[3],0,0,0), C1,14); \
    }while(0)
  #define STEPX(C0,C1,P0,P1,t,GK,GV,GL) do{ if constexpr(NVQ==4){ STEP4(C0,C1,P0,P1,t,GK,GV,GL); } else { STEP(C0,C1,P0,P1,t,GK,GV,GL); } }while(0)
  int t=1;
  #undef CMASK
  #define CMASK(P0,P1,t) do{}while(0)
  for(;t+5<NT;t+=2){
    STEPX(pB0,pB1,pA0,pA1,t,true,true,true);     WAITB(2,3); RESC(); ROT();
    STEPX(pA0,pA1,pB0,pB1,t+1,true,true,true);   WAITB(2,3); RESC(); ROT();
  }
  #undef CMASK
  #define CMASK(P0,P1,t) do{}while(0)
  #define ENDW(tt) do{ if((tt)+3<NT){WAITB(2,3);} else if((tt)+2<NT){WAITB(1,2);} else {WAIT_BAR(0);} }while(0)
  for(;t+1<NT;t+=2){
    STEPX(pB0,pB1,pA0,pA1,t,(t+3<NT),(t+1<NT),(t+1<NT));       ENDW(t);   RESC(); ROT();
    STEPX(pA0,pA1,pB0,pB1,t+1,(t+4<NT),(t+2<NT),(t+2<NT));     ENDW(t+1); RESC(); ROT();
  }
  STEPX(pB0,pB1,pA0,pA1,NT-1,false,false,false); RESC();
  { float sacc=pB0[0]+pB0[1]; _Pragma("unroll") for(int r=2;r<16;++r)sacc+=pB0[r]; _Pragma("unroll") for(int r=0;r<16;++r)sacc+=pB1[r]; l_reg+=sacc;
    pw0=(u32x4){PKW(pB0,0),PKW(pB0,2),PKW(pB0,4),PKW(pB0,6)};pw1=(u32x4){PKW(pB0,8),PKW(pB0,10),PKW(pB0,12),PKW(pB0,14)};pw2=(u32x4){PKW(pB1,0),PKW(pB1,2),PKW(pB1,4),PKW(pB1,6)};pw3=(u32x4){PKW(pB1,8),PKW(pB1,10),PKW(pB1,12),PKW(pB1,14)};
    SBAR(); pv<NVQ>(o,vb0+2*sl_cur,PAF(0),PAF(1),PAF(2),PAF(3)); }
  #undef PKW
  #undef PAF
  #undef VFR
  #undef PIN
  #undef MX3
  #undef GAPA
  #undef GAPB
  #undef GAPB2
  #undef VRD2
  #undef EX
  #undef VRD
  #undef KRD
  #undef STEP
  #undef STEP4
  #undef STEPX
  #undef VRF
  #undef ENDW
  { int lane_e=lane; asm volatile("":"+v"(lane_e)); const int r32=lane_e&31,hi=lane_e>>5,lane=lane_e;
  {auto rr=__builtin_amdgcn_permlane32_swap(__float_as_uint(l_reg),__float_as_uint(l_reg),false,false);l_reg=__uint_as_float(rr[0])+__uint_as_float(rr[1]);}
  if(hi==0)wsf[32+r32]=l_reg;asm volatile("s_waitcnt lgkmcnt(0)":::"memory");
  float rli[16];
  #pragma unroll
  for(int r=0;r<16;++r)rli[r]=__builtin_amdgcn_rcpf(wsf[32+crow(r,hi)]);
  if(MODE==0){
    bf16*Ow=Odst+(long)(wid*QBLK)*1024;
    bf16*stg=(bf16*)(shm+LDS_OST)+wid*4096;
    #pragma unroll
    for(int r=0;r<16;++r){const int orow=crow(r,hi);
      #pragma unroll
      for(int d0=0;d0<2;++d0)stg[orow*64+d0*32+r32]=__float2bfloat16(o[d0][r]*rli[r]);}
    asm volatile("s_waitcnt lgkmcnt(0)":::"memory");
    #pragma unroll
    for(int i=0;i<4;++i){const int row=i*8+(lane>>3),ch=lane&7; const u32x4 v=*(const u32x4*)(stg+row*64+ch*8); ATTN_STORE16(Ow+(long)row*1024+ch*8,v);}
  } else {
    bf16*stg=(bf16*)(shm+LDS_OST)+wid*4096+ecol;
    #pragma unroll
    for(int r=0;r<16;++r){const int orow=crow(r,hi);
      #pragma unroll
      for(int d0=0;d0<NVQ;++d0){ float val=o[d0][r]*rli[r];
        if(MODE==2){ val=__bfloat162float(stg[orow*128+d0*32+r32])-lam*val; }
        stg[orow*128+d0*32+r32]=__float2bfloat16(val);} }
  }
  }
  __builtin_amdgcn_s_setprio(0);
  asm volatile("s_waitcnt lgkmcnt(0)\n\ts_barrier":::"memory");
  #undef DMA_K
  #undef DMA_V
  #undef WAITB
  #undef CMASK
  #undef START
  #undef RESC
  #undef ROT
}
constexpr int ATTN_LDS_BYTES=LDS_BYTES;

struct AttnArgs { const bf16* QB; const bf16* KB; const bf16* VB; bf16* OB; const float* subln; float lam; };
template<int THRL> __device__ __forceinline__ void attn_unit(const AttnArgs&A,int qrow0,int krow0,int NT,int isdiff,int head,char*shm){
  int tid_=threadIdx.x; asm volatile("":"+v"(tid_)); const int tid=tid_,lane=tid&63; const int wid=__builtin_amdgcn_readfirstlane(tid>>6);
  const int qcol=isdiff?head*128:512+head*64, kcol=isdiff?head*128:512+(head>>2)*64;
  const bf16*Qb=A.QB+(long)qrow0*1024+qcol; const bf16*Kb=A.KB+(long)krow0*640+kcol; const bf16*Vb=A.VB+(long)krow0*640+kcol;
  bf16*Ob=A.OB+(long)qrow0*1024+qcol;
  if(isdiff){
    for(int mp=0;mp<2;++mp) attn_pass<THRL,1024,640,4>(Qb+mp*64,Kb+mp*64,Vb,NT,Ob,0,A.lam,1+mp,shm);
  } else {
    attn_pass<THRL,1024,640,2>(Qb,Kb,Vb,NT,Ob,0,A.lam,0,shm);
  }
  if(isdiff){
    int lane_e=lane; asm volatile("":"+v"(lane_e));
    const bf16*stg=(const bf16*)(shm+LDS_OST)+wid*4096; bf16*Ow=Ob+(long)(wid*QBLK)*1024; const int ch=lane_e&15;
    float g[8];
    #pragma unroll
    for(int k=0;k<8;++k)g[k]=A.subln[ch*8+k]*0.8f;
    #pragma unroll
    for(int i=0;i<8;++i){ const int row=i*4+(lane_e>>4); const u32x4 v=*(const u32x4*)(stg+row*128+ch*8);
      float f[8];
      #pragma unroll
      for(int k=0;k<4;++k){f[2*k]=__uint_as_float(v[k]<<16);f[2*k+1]=__uint_as_float(v[k]&0xffff0000u);}
      float ss=0.f;
      #pragma unroll
      for(int k=0;k<8;++k)ss+=f[k]*f[k];
      ss+=__shfl_xor(ss,1);ss+=__shfl_xor(ss,2);ss+=__shfl_xor(ss,4);ss+=__shfl_xor(ss,8);
      const float rs=1.0f/sqrtf(ss*(1.0f/128.0f)+1e-6f);
      u32x4 w; w.x=cvtpk_s(f[0]*rs*g[0],f[1]*rs*g[1]); w.y=cvtpk_s(f[2]*rs*g[2],f[3]*rs*g[3]); w.z=cvtpk_s(f[4]*rs*g[4],f[5]*rs*g[5]); w.w=cvtpk_s(f[6]*rs*g[6],f[7]*rs*g[7]);
      *(u32x4*)(Ow+(long)row*1024+ch*8)=w; }
    asm volatile("s_waitcnt lgkmcnt(0)":::"memory");
  }
}
template<int THRL=8> __device__ __forceinline__ void attn_phase(char*lds,const AttnArgs&A,int vcu,int G){
  for(int s=vcu;s<1280;s+=G){
    const int j=s>>8,r=s&255; int qrow0,krow0,NT,isdiff,head;
    if(j==0){ qrow0=8192+(r>>6)*4096+(r&15)*256; krow0=8192+(r>>6)*4608; NT=72; isdiff=1; head=(r>>4)&3; }
    else if(j<=2){ const int u=2*r+(j-1); qrow0=8192+(u>>7)*4096+(u&15)*256; krow0=8192+(u>>7)*4608; NT=72; isdiff=0; head=(u>>4)&7; }
    else if(j==3){ if(r<128){ qrow0=(r>>2)*256; krow0=qrow0; NT=4; isdiff=1; head=r&3; } else { const int u=r-128; qrow0=(u>>3)*256; krow0=qrow0; NT=4; isdiff=0; head=u&7; } }
    else { if(r<128)continue; const int u=r; qrow0=(u>>3)*256; krow0=qrow0; NT=4; isdiff=0; head=u&7; }
    attn_unit<THRL>(A,qrow0,krow0,NT,isdiff,head,lds);
  }
}
#undef SBAR
#undef WAIT_BAR
}
#define GAS __attribute__((address_space(1)))
#define LAS __attribute__((address_space(3)))
typedef unsigned short bfu;
typedef unsigned v4u __attribute__((ext_vector_type(4)));
typedef unsigned v2u __attribute__((ext_vector_type(2)));
typedef float f32x4 __attribute__((ext_vector_type(4)));
#define LDS_WAIT() asm volatile("s_waitcnt lgkmcnt(0)" ::: "memory")
constexpr int NWAVES = 8, LDS_BYTES = 147456;
constexpr size_t MiB = 1u << 20;
constexpr size_t WS_MOD = 0, WS_BAR = 192 * 1024, WS_CTL_BYTES = 192 * 1024 + 16 * 1024, WS_ROPE = 256 * 1024, WS_WGU1 = 1 * MiB, WS_WD1 = 12 * MiB, WS_WIN = 18 * MiB, WS_WOUT = 23 * MiB, WS_WGU2 = 25 * MiB, WS_WD2 = 36 * MiB;
constexpr size_t WS_H = 42 * MiB, WS_ACT = 90 * MiB, WS_QB = 90 * MiB, WS_KB = 138 * MiB, WS_VB = 171 * MiB, WS_END = 222 * MiB;
constexpr int M_TOK = 24576, D_M = 1024, D_FF = 2816, D_IN = 2304, KVROWS = 26624, NMODV_ = 9216;
static_assert(WS_KB + (size_t)KVROWS * 640 * 2 <= WS_VB && WS_VB + (size_t)KVROWS * 640 * 2 <= WS_END && WS_ACT + (size_t)M_TOK * D_FF * 2 <= WS_END, "ws map");
constexpr int LDS_CTL = 143360;
static_assert(attn_body::ATTN_LDS_BYTES <= LDS_CTL && LDS_CTL + 1024 <= LDS_BYTES, "LDS map");

__device__ __forceinline__ unsigned pk2(float lo, float hi) { return pg8::cvt_pk_bf16(lo, hi); }
__device__ __forceinline__ float wave_sum(float v) {
#pragma unroll
    for (int o = 1; o < 64; o <<= 1) v += __shfl_xor(v, o);
    return v;
}
__device__ __forceinline__ void transpose_item(const float* W, int K, int N, bfu* WT, int kind, LAS float* scr, int item, int lane) {
    const int nblk = N / 32, kb = item / nblk, nb = item % nblk, k0 = 64 * kb, n0 = 32 * nb;
    int pr = n0;
    if (kind == 1) { const int L = n0 < D_FF ? n0 : n0 - D_FF; pr = 256 * (L / 128) + (L % 128) + (n0 < D_FF ? 0 : 128); }
    else if (kind == 2) { const int ch = n0 / 64, half = (n0 / 32) & 1; pr = 256 * (ch / 4) + 128 * half + 32 * (ch % 4); }
    {
        const int kr = lane >> 3, c4 = lane & 7; f32x4 wv[8];
#pragma unroll
        for (int i = 0; i < 8; ++i) wv[i] = __builtin_nontemporal_load((const f32x4*)(W + (size_t)(k0 + 8 * i + kr) * N + n0 + 4 * c4));
#pragma unroll
        for (int i = 0; i < 8; ++i) { LAS float* d = scr + (8 * i + kr) * 33 + 4 * c4; d[0] = wv[i].x; d[1] = wv[i].y; d[2] = wv[i].z; d[3] = wv[i].w; }
    }
    LDS_WAIT(); asm volatile("" ::: "memory");
    const int c = lane & 7;
#pragma unroll
    for (int j = 0; j < 4; ++j) { const int n = (lane >> 3) + 8 * j; const LAS float* s = scr + (8 * c) * 33 + n;
        v4u o; o.x = pk2(s[0 * 33], s[1 * 33]); o.y = pk2(s[2 * 33], s[3 * 33]); o.z = pk2(s[4 * 33], s[5 * 33]); o.w = pk2(s[6 * 33], s[7 * 33]);
        *(GAS v4u*)(WT + (size_t)(pr + n) * K + k0 + 8 * c) = o; }
    LDS_WAIT(); asm volatile("" ::: "memory");
}
__device__ __forceinline__ void ada_item(const float* c, const float* c_ctx, const float* w_ada, const float* b_ada, float* mod, LAS float* scr, int item, int lane) {
    const int cb = item % 144, kc = item / 144, n = cb * 64 + lane, k0 = kc * 128;
#pragma unroll
    for (int i = 0; i < 10; ++i) { const int idx = lane + 64 * i, v = idx >> 7, kk = idx & 127; const float cv = v < 4 ? c[v * 1024 + k0 + kk] : c_ctx[k0 + kk]; scr[idx] = cv / (1.0f + expf(-cv)); }
    LDS_WAIT(); asm volatile("" ::: "memory");
    float acc[5] = {0.f, 0.f, 0.f, 0.f, 0.f};
#pragma unroll 8
    for (int kk = 0; kk < 128; ++kk) { const float w = __builtin_nontemporal_load(w_ada + (size_t)(k0 + kk) * NMODV_ + n);
#pragma unroll
        for (int v = 0; v < 5; ++v) acc[v] += scr[v * 128 + kk] * w; }
    const float bb = kc == 0 ? b_ada[n] : 0.f;
#pragma unroll
    for (int v = 0; v < 5; ++v) unsafeAtomicAdd(mod + v * NMODV_ + n, acc[v] + bb);
    LDS_WAIT(); asm volatile("" ::: "memory");
}
__device__ __forceinline__ float sumsq4(const f32x4 (&v)[4]) { float s = 0.f;
#pragma unroll
    for (int j = 0; j < 4; ++j) s += (v[j].x * v[j].x + v[j].y * v[j].y) + (v[j].z * v[j].z + v[j].w * v[j].w);
    return s; }
template <bool NTL> __device__ __forceinline__ void norm_mod_phase(const float* X0, const float* X1, const float* g, const float* mod, int shift_idx, bfu* H, int gw, int NGW, int lane) {
    const int per = (M_TOK + NGW - 1) / NGW, per2 = (per + 1) & ~1, r0 = gw * per2, r1 = (r0 + per2 < M_TOK) ? r0 + per2 : M_TOK;
    if (r0 >= r1) return;
    f32x4 gm[4], sh[4]; int cur_mv = -1;
    f32x4 na[4], nb[4];
#define NRM_LD(p) (NTL ? __builtin_nontemporal_load(p) : *(p))
#define NRM_ROWP(m) ((m) < 8192 ? X0 + (size_t)(m) * D_M : X1 + (size_t)((m) - 8192) * D_M)
#pragma unroll
    for (int j = 0; j < 4; ++j) { na[j] = NRM_LD((const f32x4*)NRM_ROWP(r0) + lane + 64 * j); nb[j] = NRM_LD((const f32x4*)NRM_ROWP(r0 + 1) + lane + 64 * j); }
    for (int m = r0; m < r1; m += 2) {
        f32x4 va[4], vb[4];
#pragma unroll
        for (int j = 0; j < 4; ++j) { va[j] = na[j]; vb[j] = nb[j]; }
        if (m + 2 < r1) {
#pragma unroll
            for (int j = 0; j < 4; ++j) { na[j] = NRM_LD((const f32x4*)NRM_ROWP(m + 2) + lane + 64 * j); nb[j] = NRM_LD((const f32x4*)NRM_ROWP(m + 3) + lane + 64 * j); }
        }
#pragma unroll
        for (int half = 0; half < 2; ++half) {
            const int mm = m + half; const int mv = mm < 8192 ? 4 : ((mm - 8192) >> 12);
            if (mv != cur_mv) { cur_mv = mv; const f32x4* shp = (const f32x4*)(mod + mv * NMODV_ + shift_idx * D_M) + lane; const f32x4* gg = (const f32x4*)g + lane;
#pragma unroll
                for (int j = 0; j < 4; ++j) { sh[j] = shp[64 * j]; gm[j] = gg[64 * j] * (shp[256 + 64 * j] + 1.0f); } }
            const float rstd = 1.0f / sqrtf(wave_sum(half ? sumsq4(vb) : sumsq4(va)) * (1.0f / D_M) + 1e-6f);
            v2u* o8 = (v2u*)(H + (size_t)mm * D_M) + lane;
#pragma unroll
            for (int j = 0; j < 4; ++j) { const f32x4 x = half ? vb[j] : va[j]; const f32x4 h = x * rstd * gm[j] + sh[j]; v2u w; w.x = pk2(h.x, h.y); w.y = pk2(h.z, h.w); o8[64 * j] = w; }
        }
    }
#undef NRM_ROWP
#undef NRM_LD
}
__device__ __forceinline__ void final_norm_phase(float* X, const float* g, int gw, int NGW, int lane) {
    const int per = (M_TOK + NGW - 1) / NGW, per2 = (per + 1) & ~1, r0 = gw * per2, r1 = (r0 + per2 < M_TOK) ? r0 + per2 : M_TOK;
    if (r0 >= r1) return;
    f32x4 gm[4], na[4], nb[4];
#pragma unroll
    for (int j = 0; j < 4; ++j) { gm[j] = ((const f32x4*)g + lane)[64 * j]; na[j] = ((const f32x4*)(X + (size_t)r0 * D_M) + lane)[64 * j]; nb[j] = ((const f32x4*)(X + (size_t)(r0 + 1) * D_M) + lane)[64 * j]; }
    for (int m = r0; m < r1; m += 2) {
        f32x4 va[4], vb[4];
#pragma unroll
        for (int j = 0; j < 4; ++j) { va[j] = na[j]; vb[j] = nb[j]; }
        if (m + 2 < r1) {
#pragma unroll
            for (int j = 0; j < 4; ++j) { na[j] = ((const f32x4*)(X + (size_t)(m + 2) * D_M) + lane)[64 * j]; nb[j] = ((const f32x4*)(X + (size_t)(m + 3) * D_M) + lane)[64 * j]; }
        }
        const float ra = 1.0f / sqrtf(wave_sum(sumsq4(va)) * (1.0f / D_M) + 1e-6f), rb = 1.0f / sqrtf(wave_sum(sumsq4(vb)) * (1.0f / D_M) + 1e-6f);
        f32x4* xa = (f32x4*)(X + (size_t)m * D_M) + lane; f32x4* xb = (f32x4*)(X + (size_t)(m + 1) * D_M) + lane;
#pragma unroll
        for (int j = 0; j < 4; ++j) { __builtin_nontemporal_store(va[j] * ra * gm[j], xa + 64 * j); __builtin_nontemporal_store(vb[j] * rb * gm[j], xb + 64 * j); }
    }
}
__device__ __forceinline__ void rope_entry(float* rope, int idx) {
    const int pos = idx >> 4, j = idx & 15;
    double inv = 1.0; for (int i = 0; i < j; ++i) inv *= 0.56234132519034908;
    const float angf = (float)pos * (float)inv;
    const double ang = (double)angf;
    const double kq = rint(ang * 0.63661977236758134);
    double r = fma(-kq, 1.5707963267341256, ang); r = fma(-kq, 6.0771005065061922e-11, r);
    const double r2 = r * r;
    const double sn = r * (1.0 + r2 * (-1.0 / 6 + r2 * (1.0 / 120 + r2 * (-1.0 / 5040 + r2 * (1.0 / 362880 + r2 * (-1.0 / 39916800 + r2 * (1.0 / 6227020800.0)))))));
    const double cs = 1.0 + r2 * (-0.5 + r2 * (1.0 / 24 + r2 * (-1.0 / 720 + r2 * (1.0 / 40320 + r2 * (-1.0 / 3628800 + r2 * (1.0 / 479001600 + r2 * (-1.0 / 87178291200.0)))))));
    const int q = ((int)kq) & 3;
    const double s_ = q == 0 ? sn : q == 1 ? cs : q == 2 ? -sn : -cs;
    const double c_ = q == 0 ? cs : q == 1 ? -sn : q == 2 ? -cs : sn;
    rope[idx] = (float)c_; rope[1024 + idx] = (float)s_;
}
__device__ __forceinline__ void cache_item(const float* cdk, const float* cdv, const float* cgk, const float* cgv, bfu* KB, bfu* VB, int item, int lane) {
    const int row = item >> 1, which = item & 1;
    const int lb = row >> 9, p = row & 511; const size_t drow = (size_t)(8192 + lb * 4608 + p) * 640;
    const float* sd = (which ? cdv : cdk) + (size_t)row * 512; const float* sg = (which ? cgv : cgk) + (size_t)row * 128; bfu* dst = (which ? VB : KB) + drow;
    { const f32x4 a = __builtin_nontemporal_load((const f32x4*)(sd + lane * 8)), b = __builtin_nontemporal_load((const f32x4*)(sd + lane * 8 + 4)); v4u w; w.x = pk2(a.x, a.y); w.y = pk2(a.z, a.w); w.z = pk2(b.x, b.y); w.w = pk2(b.z, b.w); *(v4u*)(dst + lane * 8) = w; }
    if (lane < 16) { const f32x4 a = *(const f32x4*)(sg + lane * 8), b = *(const f32x4*)(sg + lane * 8 + 4); v4u w; w.x = pk2(a.x, a.y); w.y = pk2(a.z, a.w); w.z = pk2(b.x, b.y); w.w = pk2(b.z, b.w); *(v4u*)(dst + 512 + lane * 8) = w; }
}

#define RLX_AGENT __ATOMIC_RELAXED, __HIP_MEMORY_SCOPE_AGENT
#define XB_TMO      128
#define XB_XCNT(j)  (256  + 64 * (j))
#define XB_XSUB(j)  (1280 + 64 * (j))
#define XB_XGEN(j)  (2304 + 64 * (j))
#define XB_TOP      3328
#define XB_TOPGEN   3392
#define XCD_BAR_WORDS 3456
#define XB_SPIN_CAP (1u << 18)

__device__ __forceinline__ unsigned xb_ld(unsigned* p)              { return __hip_atomic_load(p, __ATOMIC_RELAXED, __HIP_MEMORY_SCOPE_AGENT); }
__device__ __forceinline__ unsigned xb_add(unsigned* p, unsigned v) { return __hip_atomic_fetch_add(p, v, __ATOMIC_RELAXED, __HIP_MEMORY_SCOPE_AGENT); }
__device__ __forceinline__ unsigned xb_xcc_id() { return (unsigned)__builtin_amdgcn_s_getreg((3 << 11) | 20) & 0xFu; }
#define XB_SPIN(cond, bar) do { unsigned _sp = 0; while (cond) { __builtin_amdgcn_s_sleep(1); \
    if ((++_sp & 255u) == 0u) { if (xb_ld(&(bar)[XB_TMO])) break; if (_sp > XB_SPIN_CAP) { atomicAdd(&(bar)[XB_TMO], 1u); break; } } } } while (0)

struct XcdBarrier {
    unsigned* bar; unsigned x;
    volatile LAS unsigned* st;
};

__device__ __forceinline__ XcdBarrier xcd_barrier_post(unsigned* bar, volatile LAS unsigned* st) {
    XcdBarrier b; b.bar = bar; b.x = xb_xcc_id(); b.st = st;
    if (threadIdx.x == 0) (void)xb_add(&bar[XB_XCNT(b.x)], 1u);
    return b;
}
__device__ __forceinline__ void xcd_barrier_complete(unsigned* bar, unsigned x, unsigned& nloc, unsigned& nx) {
    const unsigned G = gridDim.x * gridDim.y * gridDim.z;
    unsigned sum, cnt, mine, sp = 0u;
    for (;;) {
        sum = 0u; cnt = 0u; mine = 0u;
#pragma unroll
        for (unsigned j = 0; j < 16; ++j) { const unsigned c = xb_ld(&bar[XB_XCNT(j)]); sum += c; cnt += (c > 0u) ? 1u : 0u; mine = (j == x) ? c : mine; }
        if (sum == G) break;
        __builtin_amdgcn_s_sleep(1);
        if ((++sp & 255u) == 0u) { if (xb_ld(&bar[XB_TMO])) break; if (sp > XB_SPIN_CAP) { atomicAdd(&bar[XB_TMO], 1u); break; } }
    }
    nloc = mine > 0u ? mine : 1u; nx = cnt > 0u ? cnt : 1u;
}

__device__ __forceinline__ void xcd_barrier(const XcdBarrier& b) {
    asm volatile("s_waitcnt vmcnt(0)" ::: "memory");
    __syncthreads();
    if (threadIdx.x == 0) {
        unsigned* bar = b.bar;
        __builtin_amdgcn_s_waitcnt(0);
        unsigned nloc = b.st[0], nx = b.st[1];
        if (nloc == 0u) { xcd_barrier_complete(bar, b.x, nloc, nx); b.st[0] = nloc; b.st[1] = nx; }
        const unsigned old = xb_add(&bar[XB_XSUB(b.x)], 1u);
        const unsigned gen = old / nloc;
        if (old + 1u == (gen + 1u) * nloc) {
            __builtin_amdgcn_fence(__ATOMIC_RELEASE, "agent");
            asm volatile("s_waitcnt vmcnt(0)" ::: "memory");
            const unsigned og = xb_add(&bar[XB_TOP], 1u);
            const unsigned tg = og / nx;
            if (og + 1u == (tg + 1u) * nx) xb_add(&bar[XB_TOPGEN], 1u);
            else XB_SPIN(xb_ld(&bar[XB_TOPGEN]) == tg, bar);
            __builtin_amdgcn_fence(__ATOMIC_ACQUIRE, "agent");
            xb_add(&bar[XB_XGEN(b.x)], 1u);
            asm volatile("s_waitcnt vmcnt(0)" ::: "memory");
        } else {
            XB_SPIN(xb_ld(&bar[XB_XGEN(b.x)]) == gen, bar);
            __builtin_amdgcn_fence(__ATOMIC_ACQUIRE, "agent");
            asm volatile("s_waitcnt vmcnt(0)" ::: "memory");
        }
    }
    __syncthreads();
}

struct Args { const float* in[27]; float* o_; unsigned char* w_; };
__global__ void __launch_bounds__(NWAVES * 64, 2) fwd_megakernel(Args a) {
    extern __shared__ __attribute__((aligned(16))) unsigned char lds[];
    cg::grid_group grid = cg::this_grid();
    int tid = threadIdx.x, lane = tid & 63; const int wave = __builtin_amdgcn_readfirstlane(tid >> 6);
#define REFRESH() do { tid = threadIdx.x; asm volatile("" : "+v"(tid)); lane = tid & 63; gw = bx * NWAVES + wave; } while (0)
    const int G = gridDim.x, bx = blockIdx.x; const int vcu = (G % 8 == 0) ? (bx % 8) * (G / 8) + bx / 8 : bx;
    int gw = bx * NWAVES + wave; const int NGW = G * NWAVES;
#define ws (a.w_)
#define mod ((float*)(a.w_ + WS_MOD))
#define rope ((float*)(a.w_ + WS_ROPE))
#define WGU1 ((bfu*)(a.w_ + WS_WGU1))
#define WD1 ((bfu*)(a.w_ + WS_WD1))
#define WIN ((bfu*)(a.w_ + WS_WIN))
#define WOUT ((bfu*)(a.w_ + WS_WOUT))
#define WGU2 ((bfu*)(a.w_ + WS_WGU2))
#define WD2 ((bfu*)(a.w_ + WS_WD2))
#define H ((bfu*)(a.w_ + WS_H))
#define ACT ((bfu*)(a.w_ + WS_ACT))
#define QB ((bfu*)(a.w_ + WS_QB))
#define KB ((bfu*)(a.w_ + WS_KB))
#define VB ((bfu*)(a.w_ + WS_VB))
#define OB ((bfu*)(a.w_ + WS_H))
#define out (a.o_)
    PG8_LAS unsigned char* l3 = (PG8_LAS unsigned char*)lds;
    if (tid < 64) ((LAS unsigned*)(l3 + LDS_CTL))[tid] = 0u;
    __syncthreads();
    if (a.o_ == nullptr) grid.sync();
    XcdBarrier bar = xcd_barrier_post((unsigned*)(ws + WS_BAR), (volatile LAS unsigned*)(l3 + LDS_CTL));
#ifdef PROBE_A
    volatile LAS unsigned long long* stamps = (volatile LAS unsigned long long*)(l3 + LDS_CTL + 256); int n_stamp = 0;
#define STAMP() do { if (bx == 0 && tid == 0) stamps[n_stamp] = __builtin_amdgcn_s_memrealtime(); ++n_stamp; } while (0)
#else
#define STAMP() do {} while (0)
#endif
    STAMP();

    {
        LAS float* scr = (LAS float*)(l3 + wave * 16384);
        constexpr int I_GU = 16 * 176, I_DN = 44 * 32, I_IN = 16 * 72, I_OUT = 16 * 32, I_ADA = 1152;
        constexpr int NITEMS = I_GU + I_ADA;
        for (int it = gw; it < NITEMS; it += NGW) {
            int r = it;
            if (r < I_ADA) { ada_item(a.in[2], a.in[7], a.in[8], a.in[9], mod, scr, r, lane); continue; } r -= I_ADA;
            transpose_item(a.in[11], D_M, 2 * D_FF, WGU1, 1, scr, r, lane);
        }
        const int gt = bx * 512 + tid; if (gt < 1024) rope_entry(rope, gt);
    }
    xcd_barrier(bar); STAMP(); REFRESH();
    norm_mod_phase<true>(a.in[0], a.in[1], a.in[10], mod, 0, H, gw, NGW, lane);
    xcd_barrier(bar); STAMP(); REFRESH();
#ifndef NO_P2
    { pg8::Gemm g{H, WGU1, M_TOK, 2 * D_FF, D_M}; pg8::StaticOrder S; S.init(M_TOK, 2 * D_FF, G, bx); pg8::EpiSwiglu E{ACT};
      pg8::gemm_phase<pg8::EpiSwiglu, pg8::StaticOrder, true, true>(l3, g, S, E); }
#endif
    {
        constexpr int I_DN = 44 * 32, I_IN = 16 * 72, NIT1 = I_DN + I_IN;
        const int nun = (M_TOK / 256) * (2 * D_FF / 256), R_ = nun % G, busy = (R_ > 0 && 2 * R_ <= G) ? 2 * R_ : R_, first = busy, nhelp = busy == 0 ? G : G - busy;
        if (bx >= first) { LAS float* scr = (LAS float*)(l3 + wave * 16384);
            for (int it = (bx - first) * NWAVES + wave; it < NIT1; it += nhelp * NWAVES) {
                if (it < I_DN) transpose_item(a.in[12], D_FF, D_M, WD1, 0, scr, it, lane); else transpose_item(a.in[14], D_M, D_IN, WIN, 2, scr, it - I_DN, lane); } }
    }
    xcd_barrier(bar); STAMP(); REFRESH();
#ifndef NO_P3
    { pg8::Gemm g{ACT, WD1, M_TOK, D_M, D_FF}; pg8::StaticOrder S; S.init(M_TOK, D_M, G, bx); pg8::EpiResidT<true> E{a.in[0], a.in[1] - (size_t)8192 * D_M, out, mod, 2, 0.5f};
      pg8::gemm_phase<pg8::EpiResidT<true>, pg8::StaticOrder, true, true>(l3, g, S, E); }
#endif
    xcd_barrier(bar); STAMP(); REFRESH();
    norm_mod_phase<false>(out, out + (size_t)8192 * D_M, a.in[13], mod, 3, H, gw, NGW, lane);
    for (int it = gw; it < 4096; it += NGW) cache_item(a.in[3], a.in[4], a.in[5], a.in[6], KB, VB, it, lane);
    {
        constexpr int I_GU = 16 * 176, I_DN = 44 * 32, I_OUT = 16 * 32, NIT2 = I_OUT + I_GU + I_DN; LAS float* scr = (LAS float*)(l3 + wave * 16384);
        for (int it = gw; it < NIT2; it += NGW) { int r = it;
            if (r < I_OUT) { transpose_item(a.in[22], D_M, D_M, WOUT, 0, scr, r, lane); continue; } r -= I_OUT;
            if (r < I_GU) { transpose_item(a.in[24], D_M, 2 * D_FF, WGU2, 1, scr, r, lane); continue; } r -= I_GU;
            transpose_item(a.in[25], D_FF, D_M, WD2, 0, scr, r, lane); }
    }
    xcd_barrier(bar); STAMP(); REFRESH();
#ifndef NO_P5
    { pg8::Gemm g{H, WIN, M_TOK, D_IN, D_M}; pg8::StaticOrder S; S.init(M_TOK, D_IN, G, bx); pg8::EpiQKV E{QB, KB, VB, out, a.in[15], a.in[16], rope};
      pg8::gemm_phase<pg8::EpiQKV, pg8::StaticOrder, true, true>(l3, g, S, E); }
#endif
    xcd_barrier(bar); STAMP(); REFRESH();
    {
        const float p1 = wave_sum(a.in[17][lane] * a.in[18][lane]), p2 = wave_sum(a.in[19][lane] * a.in[20][lane]);
        const float lam = expf(p1) - expf(p2) + 0.2f;
        attn_body::AttnArgs A{(const attn_body::bf16*)QB, (const attn_body::bf16*)KB, (const attn_body::bf16*)VB, (attn_body::bf16*)OB, a.in[21], lam};
#ifndef NO_ATTN
        attn_body::attn_phase<8>((char*)lds, A, vcu, G);
#endif
    }
    xcd_barrier(bar); STAMP(); REFRESH();
#ifndef NO_P7
    { pg8::Gemm g{OB, WOUT, M_TOK, D_M, D_M}; pg8::StaticOrder S; S.init(M_TOK, D_M, G, bx); pg8::EpiResidT<false> E{out, out, out, mod, 5, 1.0f};
      pg8::gemm_phase<pg8::EpiResidT<false>, pg8::StaticOrder, true, true>(l3, g, S, E); }
#endif
    xcd_barrier(bar); STAMP(); REFRESH();
    norm_mod_phase<false>(out, out + (size_t)8192 * D_M, a.in[23], mod, 6, H, gw, NGW, lane);
    xcd_barrier(bar); STAMP(); REFRESH();
#ifndef NO_P9
    { pg8::Gemm g{H, WGU2, M_TOK, 2 * D_FF, D_M}; pg8::StaticOrder S; S.init(M_TOK, 2 * D_FF, G, bx); pg8::EpiSwiglu E{ACT};
      pg8::gemm_phase<pg8::EpiSwiglu, pg8::StaticOrder, true, true>(l3, g, S, E); }
#endif
    xcd_barrier(bar); STAMP(); REFRESH();
#ifndef NO_P10
    { pg8::Gemm g{ACT, WD2, M_TOK, D_M, D_FF}; pg8::StaticOrder S; S.init(M_TOK, D_M, G, bx); pg8::EpiResidT<false> E{out, out, out, mod, 8, 0.5f};
      pg8::gemm_phase<pg8::EpiResidT<false>, pg8::StaticOrder, true, true>(l3, g, S, E); }
#endif
    xcd_barrier(bar); STAMP(); REFRESH();
    final_norm_phase(out, a.in[26], gw, NGW, lane);
    STAMP();
#ifdef PROBE_A
    if (bx == 0 && tid == 0) { asm volatile("s_waitcnt vmcnt(0)" ::: "memory"); out[0] += (float)(stamps[PROBE_B] - stamps[PROBE_A]) * 1e-4f; }
#endif
}

#undef ws
#undef mod
#undef rope
#undef WGU1
#undef WD1
#undef WIN
#undef WOUT
#undef WGU2
#undef WD2
#undef H
#undef ACT
#undef QB
#undef KB
#undef VB
#undef OB
#undef out
extern "C" void kernel_launch(void* const* d_in, const int* in_sizes, int n_in, void* d_out, int out_size, void* d_ws, size_t ws_size, hipStream_t stream) {
    static int grid = 0;
    if (grid == 0) {
        if (n_in != 27 || ws_size < WS_END) { fprintf(stderr, "kernel_launch: unexpected n_in %d / ws %zu\n", n_in, ws_size); grid = -1; return; }
        int dev = 0, cus = 0, per_cu = 0;
        (void)hipGetDevice(&dev);
        (void)hipDeviceGetAttribute(&cus, hipDeviceAttributeMultiprocessorCount, dev);
        (void)hipFuncSetAttribute((const void*)fwd_megakernel, hipFuncAttributeMaxDynamicSharedMemorySize, LDS_BYTES);
        (void)hipOccupancyMaxActiveBlocksPerMultiprocessor(&per_cu, (const void*)fwd_megakernel, NWAVES * 64, LDS_BYTES);
        if (per_cu < 1) { fprintf(stderr, "kernel_launch: occupancy query says %d blocks/CU\n", per_cu); per_cu = 1; }
        grid = cus * per_cu;
    }
    if (grid < 0) return;
    (void)hipMemsetAsync((char*)d_ws + WS_MOD, 0, WS_CTL_BYTES, stream);
    Args a{};
    for (int i = 0; i < 27; ++i) a.in[i] = (const float*)d_in[i];
    a.o_ = (float*)d_out; a.w_ = (unsigned char*)d_ws;
    void* args[] = {&a};
    hipError_t e = hipLaunchCooperativeKernel((const void*)fwd_megakernel, dim3(grid), dim3(NWAVES * 64), args, LDS_BYTES, stream);
    if (e != hipSuccess) fprintf(stderr, "cooperative launch failed: %s (grid %d)\n", hipGetErrorString(e), grid);
}
```
